# Optimizing an MI355X kernel written in HIP

```python
import math
import jax, jax.numpy as jnp
from jax import lax
import numpy as np

D_MODEL = 1024
BATCH = 2
SEQ = 8192
DEPTH = 2
DEC_BATCH = 32
DEC_SEQ = 8
PAST_LEN = 8192
PAGE_SIZE = 128

N_MIXERS = 2
N_ATTN_LAYERS = (DEPTH + 1) // 2
N_SSM_LAYERS = DEPTH // 2
HEAD_DIM = 64
HEADS_PER_GROUP = 4
DILATED_GROUPS = ((128, 1), (512, 4), (2048, 16))
N_DIL_GROUPS = len(DILATED_GROUPS)
N_HEADS = N_DIL_GROUPS * HEADS_PER_GROUP
ATTN_WIDTH = N_HEADS * HEAD_DIM
BAND_BLOCK = 128
SSM_CH = 16
SSM_GROUPS = D_MODEL // SSM_CH
SSM_STATE = 64
SSM_CHUNK = 128
DT_MIN = 1e-3
DT_MAX = 1e-1
D_FF = 2816
NORM_EPS = 1e-6

kernel_name = 'hybrid_dilated_attn_s5_macaron_step'


def rms_norm(x, g):
    x32 = x.astype(jnp.float32)
    y = x32 * lax.rsqrt(jnp.mean(x32 * x32, axis=-1, keepdims=True) + NORM_EPS)
    return (y * g.astype(jnp.float32)).astype(x.dtype)


def swiglu(x, w_gate, w_up, w_down):
    return (jax.nn.silu(x @ w_gate) * (x @ w_up)) @ w_down


def alibi_slopes():
    h = jnp.arange(1, N_HEADS + 1, dtype=jnp.float32)
    return (2.0 ** (-8.0 * h / N_HEADS)).reshape(N_DIL_GROUPS, HEADS_PER_GROUP)


def dilated_attn_prompt(q, k, v, window, dil, slopes):
    bt, s_len, nh, dh = q.shape
    sub = s_len // dil
    nw = window // dil
    nb = -(-sub // BAND_BLOCK)
    sub_p = nb * BAND_BLOCK

    def to_sub(t, front):
        t = t.astype(jnp.float32).reshape(bt, sub, dil, nh, dh).transpose(0, 2, 1, 3, 4).reshape(bt * dil, sub, nh, dh)
        return jnp.pad(t, ((0, 0), (front, sub_p - sub), (0, 0), (0, 0)))

    qb = to_sub(q, 0).reshape(bt * dil, nb, BAND_BLOCK, nh, dh)
    kb = to_sub(k, BAND_BLOCK).reshape(bt * dil, nb + 1, BAND_BLOCK, nh, dh)
    vb = to_sub(v, BAND_BLOCK).reshape(bt * dil, nb + 1, BAND_BLOCK, nh, dh)
    kc = jnp.concatenate([kb[:, :-1], kb[:, 1:]], axis=2)
    vc = jnp.concatenate([vb[:, :-1], vb[:, 1:]], axis=2)
    s = jnp.einsum('bnqhd,bnkhd->bnhqk', qb, kc) * (HEAD_DIM ** -0.5)
    delta = (jnp.arange(BAND_BLOCK)[:, None] + BAND_BLOCK) - jnp.arange(2 * BAND_BLOCK)[None, :]
    key_sub = jnp.arange(nb)[:, None] * BAND_BLOCK + jnp.arange(2 * BAND_BLOCK)[None, :] - BAND_BLOCK
    valid = ((delta >= 0) & (delta <= nw))[None] & (key_sub >= 0)[:, None, :]
    bias = -slopes[:, None, None] * (delta * dil).astype(jnp.float32)[None]
    s = jnp.where(valid[None, :, None], s + bias, -jnp.inf)
    m = jnp.max(s, axis=-1, keepdims=True)
    p = jnp.exp(s - m)
    den = jnp.sum(p, axis=-1)
    o = jnp.einsum('bnhqk,bnkhd->bnqhd', p, vc) / jnp.swapaxes(den, 2, 3)[..., None]
    lse = jnp.swapaxes(m[..., 0] + jnp.log(den), 2, 3)

    def from_sub(t):
        t = t.reshape((bt * dil, sub_p) + t.shape[3:])[:, :sub]
        t = jnp.swapaxes(t.reshape((bt, dil, sub) + t.shape[2:]), 1, 2)
        return t.reshape((bt, s_len) + t.shape[3:])

    return from_sub(o), from_sub(lse)


def dilated_attn_sample(q, kv_buf, kv_new, window, dil, slopes):
    t_len = q.shape[1]
    wb = kv_buf.shape[1]
    kv_all = jnp.concatenate([kv_buf.astype(kv_new.dtype), kv_new], axis=1)
    steps = jnp.arange(window // dil + 1)
    idx = wb + jnp.arange(t_len)[:, None] - steps[None, :] * dil
    valid = idx >= 0
    kv_sel = jnp.take(kv_all, jnp.maximum(idx, 0), axis=1).astype(jnp.float32)
    s = jnp.einsum('bthd,btkhd->bthk', q.astype(jnp.float32), kv_sel[:, :, :, 0]) * (HEAD_DIM ** -0.5)
    s = s - slopes[:, None] * (steps * dil).astype(jnp.float32)[None, :]
    s = jnp.where(valid[None, :, None, :], s, -jnp.inf)
    m = jnp.max(s, axis=-1, keepdims=True)
    p = jnp.exp(s - m)
    den = jnp.sum(p, axis=-1)
    o = jnp.einsum('bthk,btkhd->bthd', p, kv_sel[:, :, :, 1]) / den[..., None]
    lse = m[..., 0] + jnp.log(den)
    return o, lse, kv_all[:, t_len:]


def dilated_mixer(h, w_qkv, w_o, bufs):
    bt, l_len, _ = h.shape
    qkv = (h @ w_qkv).reshape(bt, l_len, 3, N_DIL_GROUPS, HEADS_PER_GROUP, HEAD_DIM)
    slopes = alibi_slopes()
    outs, lses, new_bufs = [], [], []
    for g, (win, dil) in enumerate(DILATED_GROUPS):
        q, k, v = qkv[:, :, 0, g], qkv[:, :, 1, g], qkv[:, :, 2, g]
        kv = jnp.stack([k, v], axis=2)
        if bufs is None:
            o, lse = dilated_attn_prompt(q, k, v, win, dil, slopes[g])
            new_bufs.append(kv[:, l_len - min(win, l_len):])
        else:
            o, lse, nbuf = dilated_attn_sample(q, bufs[g], kv, win, dil, slopes[g])
            new_bufs.append(nbuf)
        outs.append(o)
        lses.append(lse)
    alpha = jax.nn.softmax(jnp.stack(lses, axis=0), axis=0)
    o = jnp.stack(outs, axis=0) * alpha[..., None]
    o = jnp.moveaxis(o, 0, 2).reshape(bt, l_len, ATTN_WIDTH).astype(h.dtype)
    return o @ w_o, new_bufs


def ssm_discretize(a_re, a_im, log_dt, b_re, b_im):
    a_re = a_re.astype(jnp.float32)
    a_im = a_im.astype(jnp.float32)
    b_re = b_re.astype(jnp.float32)
    b_im = b_im.astype(jnp.float32)
    dt = jnp.exp(log_dt.astype(jnp.float32))[:, None]
    mag = jnp.exp(a_re * dt)
    ang = a_im * dt
    lam_re = mag * jnp.cos(ang)
    lam_im = mag * jnp.sin(ang)
    den = a_re * a_re + a_im * a_im
    num_re = lam_re - 1.0
    coef_re = ((num_re * a_re + lam_im * a_im) / den)[..., None]
    coef_im = ((lam_im * a_re - num_re * a_im) / den)[..., None]
    bb_re = coef_re * b_re - coef_im * b_im
    bb_im = coef_re * b_im + coef_im * b_re
    return lam_re, lam_im, bb_re, bb_im


def complex_affine_combine(e1, e2):
    ar1, ai1, br1, bi1 = e1
    ar2, ai2, br2, bi2 = e2
    return (ar2 * ar1 - ai2 * ai1,
            ar2 * ai1 + ai2 * ar1,
            ar2 * br1 - ai2 * bi1 + br2,
            ar2 * bi1 + ai2 * br1 + bi2)


def ssm_scan(u, h0, lam_re, lam_im, bb_re, bb_im, c_re, c_im):
    bt, l_len = u.shape[:2]
    chunk = SSM_CHUNK if l_len % SSM_CHUNK == 0 else l_len
    nc = l_len // chunk
    u_blocks = jnp.moveaxis(u.reshape(bt, nc, chunk, SSM_GROUPS, SSM_CH), 1, 0)

    def step(carry, u_blk):
        h_re, h_im = carry
        bu_re = jnp.einsum('btgc,gnc->btgn', u_blk, bb_re)
        bu_im = jnp.einsum('btgc,gnc->btgn', u_blk, bb_im)
        a_re = jnp.broadcast_to(lam_re, bu_re.shape)
        a_im = jnp.broadcast_to(lam_im, bu_im.shape)
        p_re, p_im, x_re, x_im = lax.associative_scan(complex_affine_combine, (a_re, a_im, bu_re, bu_im), axis=1)
        x_re = x_re + p_re * h_re[:, None] - p_im * h_im[:, None]
        x_im = x_im + p_re * h_im[:, None] + p_im * h_re[:, None]
        y = jnp.einsum('gcn,btgn->btgc', c_re, x_re) - jnp.einsum('gcn,btgn->btgc', c_im, x_im)
        return (x_re[:, -1], x_im[:, -1]), y

    (h_re, h_im), ys = lax.scan(step, (h0[..., 0], h0[..., 1]), u_blocks)
    y = jnp.moveaxis(ys, 0, 1).reshape(bt, l_len, SSM_GROUPS, SSM_CH)
    return y, jnp.stack([h_re, h_im], axis=-1)


def ssm_mixer(h, state, w_in, a_re, a_im, log_dt, b_re, b_im, c_re, c_im, d_skip, w_glu, b_glu, w_out):
    bt, l_len, _ = h.shape
    u = (h @ w_in).astype(jnp.float32).reshape(bt, l_len, SSM_GROUPS, SSM_CH)
    lam_re, lam_im, bb_re, bb_im = ssm_discretize(a_re, a_im, log_dt, b_re, b_im)
    if state is None:
        h0 = jnp.zeros((bt, SSM_GROUPS, SSM_STATE, 2), jnp.float32)
    else:
        h0 = state.astype(jnp.float32)
    y, new_state = ssm_scan(u, h0, lam_re, lam_im, bb_re, bb_im, c_re.astype(jnp.float32), c_im.astype(jnp.float32))
    y = (y + d_skip.astype(jnp.float32) * u).reshape(bt, l_len, D_MODEL)
    g = jax.nn.gelu(y)
    z = g * jax.nn.sigmoid(g @ w_glu.astype(jnp.float32) + b_glu.astype(jnp.float32))
    return z.astype(h.dtype) @ w_out, new_state


def trunk(x, kv_caches, ssm_states, P):
    kv_out = [[] for _ in range(N_DIL_GROUPS)]
    ssm_out = []
    for i in range(DEPTH):
        h = x + 0.5 * swiglu(rms_norm(x, P['norm_g'][i, 0]), P['ffn_w_gate'][i, 0], P['ffn_w_up'][i, 0], P['ffn_w_down'][i, 0])
        hn = rms_norm(h, P['norm_g'][i, 1])
        j = i // N_MIXERS
        if i % N_MIXERS == 0:
            bufs = None if kv_caches is None else [c[j] for c in kv_caches]
            mix, nbufs = dilated_mixer(hn, P['attn_w_qkv'][j], P['attn_w_o'][j], bufs)
            for g in range(N_DIL_GROUPS):
                kv_out[g].append(nbufs[g])
        else:
            st = None if ssm_states is None else ssm_states[j]
            mix, nst = ssm_mixer(hn, st, P['ssm_w_in'][j], P['ssm_a_re'][j], P['ssm_a_im'][j], P['ssm_log_dt'][j],
                                 P['ssm_b_re'][j], P['ssm_b_im'][j], P['ssm_c_re'][j], P['ssm_c_im'][j], P['ssm_d'][j],
                                 P['ssm_w_glu'][j], P['ssm_b_glu'][j], P['ssm_w_out'][j])
            ssm_out.append(nst)
        h = h + mix
        x = h + 0.5 * swiglu(rms_norm(h, P['norm_g'][i, 2]), P['ffn_w_gate'][i, 1], P['ffn_w_up'][i, 1], P['ffn_w_down'][i, 1])
    y = rms_norm(x, P['final_norm_g'])
    return y, [jnp.stack(b, axis=0) for b in kv_out], jnp.stack(ssm_out, axis=0)


def setup_inputs(seed: int = 0) -> dict:
    key = jax.random.key(seed)
    ks = jax.random.split(key, 32)
    f32 = jnp.float32

    def nrm(k, shape, scale):
        return jax.random.normal(k, shape, f32) * scale

    wb = [min(w, PAST_LEN) for (w, _) in DILATED_GROUPS]
    kvs = (HEADS_PER_GROUP, HEAD_DIM)
    return {
        'x_prompt': nrm(ks[0], (BATCH, SEQ, D_MODEL), 1.0),
        'x_sample': nrm(ks[1], (DEC_BATCH, DEC_SEQ, D_MODEL), 1.0),
        'cache_kv_g0': nrm(ks[2], (N_ATTN_LAYERS, DEC_BATCH, wb[0], 2) + kvs, 1.0),
        'cache_kv_g1': nrm(ks[3], (N_ATTN_LAYERS, DEC_BATCH, wb[1], 2) + kvs, 1.0),
        'cache_kv_g2': nrm(ks[4], (N_ATTN_LAYERS, DEC_BATCH, wb[2], 2) + kvs, 1.0),
        'state_ssm': nrm(ks[5], (N_SSM_LAYERS, DEC_BATCH, SSM_GROUPS, SSM_STATE, 2), 0.1),
        'norm_g': 1.0 + nrm(ks[6], (DEPTH, 3, D_MODEL), 0.01),
        'final_norm_g': 1.0 + nrm(ks[7], (D_MODEL,), 0.01),
        'ffn_w_gate': nrm(ks[8], (DEPTH, 2, D_MODEL, D_FF), D_MODEL ** -0.5),
        'ffn_w_up': nrm(ks[9], (DEPTH, 2, D_MODEL, D_FF), D_MODEL ** -0.5),
        'ffn_w_down': nrm(ks[10], (DEPTH, 2, D_FF, D_MODEL), D_FF ** -0.5),
        'attn_w_qkv': nrm(ks[11], (N_ATTN_LAYERS, D_MODEL, 3 * ATTN_WIDTH), D_MODEL ** -0.5),
        'attn_w_o': nrm(ks[12], (N_ATTN_LAYERS, ATTN_WIDTH, D_MODEL), ATTN_WIDTH ** -0.5),
        'ssm_w_in': nrm(ks[13], (N_SSM_LAYERS, D_MODEL, D_MODEL), D_MODEL ** -0.5),
        'ssm_a_re': -0.5 + nrm(ks[14], (N_SSM_LAYERS, SSM_GROUPS, SSM_STATE), 0.01),
        'ssm_a_im': math.pi * jnp.arange(SSM_STATE, dtype=f32)[None, None, :] + nrm(ks[15], (N_SSM_LAYERS, SSM_GROUPS, SSM_STATE), 0.01),
        'ssm_log_dt': jax.random.uniform(ks[16], (N_SSM_LAYERS, SSM_GROUPS), f32, math.log(DT_MIN), math.log(DT_MAX)),
        'ssm_b_re': nrm(ks[17], (N_SSM_LAYERS, SSM_GROUPS, SSM_STATE, SSM_CH), (2 * SSM_CH) ** -0.5),
        'ssm_b_im': nrm(ks[18], (N_SSM_LAYERS, SSM_GROUPS, SSM_STATE, SSM_CH), (2 * SSM_CH) ** -0.5),
        'ssm_c_re': nrm(ks[19], (N_SSM_LAYERS, SSM_GROUPS, SSM_CH, SSM_STATE), (0.5 * SSM_STATE) ** -0.5),
        'ssm_c_im': nrm(ks[20], (N_SSM_LAYERS, SSM_GROUPS, SSM_CH, SSM_STATE), (0.5 * SSM_STATE) ** -0.5),
        'ssm_d': nrm(ks[21], (N_SSM_LAYERS, SSM_GROUPS, SSM_CH), 1.0),
        'ssm_w_glu': nrm(ks[22], (N_SSM_LAYERS, D_MODEL, D_MODEL), D_MODEL ** -0.5),
        'ssm_b_glu': nrm(ks[23], (N_SSM_LAYERS, D_MODEL), 0.01),
        'ssm_w_out': nrm(ks[24], (N_SSM_LAYERS, D_MODEL, D_MODEL), D_MODEL ** -0.5),
    }


def reference(x_prompt, x_sample, cache_kv_g0, cache_kv_g1, cache_kv_g2, state_ssm, norm_g, final_norm_g,
              ffn_w_gate, ffn_w_up, ffn_w_down, attn_w_qkv, attn_w_o, ssm_w_in, ssm_a_re, ssm_a_im, ssm_log_dt,
              ssm_b_re, ssm_b_im, ssm_c_re, ssm_c_im, ssm_d, ssm_w_glu, ssm_b_glu, ssm_w_out):
    params = dict(norm_g=norm_g, final_norm_g=final_norm_g, ffn_w_gate=ffn_w_gate, ffn_w_up=ffn_w_up,
                  ffn_w_down=ffn_w_down, attn_w_qkv=attn_w_qkv, attn_w_o=attn_w_o, ssm_w_in=ssm_w_in,
                  ssm_a_re=ssm_a_re, ssm_a_im=ssm_a_im, ssm_log_dt=ssm_log_dt, ssm_b_re=ssm_b_re, ssm_b_im=ssm_b_im,
                  ssm_c_re=ssm_c_re, ssm_c_im=ssm_c_im, ssm_d=ssm_d, ssm_w_glu=ssm_w_glu, ssm_b_glu=ssm_b_glu,
                  ssm_w_out=ssm_w_out)
    y_prompt, kv_p, ssm_prompt = trunk(x_prompt, None, None, params)
    y_sample, kv_s, ssm_sample = trunk(x_sample, (cache_kv_g0, cache_kv_g1, cache_kv_g2), state_ssm, params)
    kv_g0_prompt, kv_g1_prompt, kv_g2_prompt = kv_p
    kv_g0_sample, kv_g1_sample, kv_g2_sample = kv_s
    return (y_prompt, y_sample, kv_g0_prompt, kv_g1_prompt, kv_g2_prompt, ssm_prompt, kv_g0_sample, kv_g1_sample, kv_g2_sample, ssm_sample)
```

```cpp
#include <hip/hip_runtime.h>
#include <hip/hip_cooperative_groups.h>
#include <cstdio>
#include <cstdint>
namespace cg = cooperative_groups;
#define REP_P0 1
#define REP_ATT 1
#define REP_MERGE 1
#define REP_SCANA 1
#define REP_SCANC 1
#define REP_FINAL 1
#define REP_GU 1
#define REP_ATTP 1
#define REP_ATTS 1
namespace pg8 {
#define PG8_LAS __attribute__((address_space(3)))
typedef unsigned short bf16_t;
typedef short bf16x8 __attribute__((ext_vector_type(8)));
typedef float f32x4 __attribute__((ext_vector_type(4)));
typedef unsigned u32x4 __attribute__((ext_vector_type(4)));
constexpr int BM = 256, BK = 64, HALF = 128, HTB = HALF * BK * 2  , STAGE_BYTES = 8 * HTB, NXCD = 8, WGM = 8;

__host__ __device__ __forceinline__ int lds_byte(int r, int c) { const int st = (r >> 4) * 2 + (c >> 5), rr = r & 15, cc = c & 31, ob = rr * 64 + cc * 2; return st * 1024 + (ob ^ (((ob >> 9) & 1) << 5)); }
__host__ __device__ __forceinline__ void stage_rc(int b, int& R, int& C) { const int st = b / 1024, sb = b % 1024, swz = sb ^ (((sb >> 9) & 1) << 5); R = (st >> 1) * 16 + swz / 64; C = (st & 1) * 32 + (swz % 64) / 2; }
__host__ __device__ __forceinline__ int perm32(int rho) { const int n = rho >> 4, i = rho & 15; return 8 * (i >> 2) + 4 * n + (i & 3); }

struct Unit { int pm, pn; };
struct Gemm { const bf16_t* A; const bf16_t* Bt; int M, N, K; };

struct StaticOrder {
    int nM, nN, nwg, G, c;
    __host__ __device__ void init(int M, int N, int G_, int c_) { nM = M / BM; nN = N / BM; nwg = nM * nN; G = G_; c = c_; }
    __host__ __device__ bool next(int i, Unit& u) const {
        const long L = (long)i * G + c; if (L >= nwg) return false;
        int wgid = (int)L; { const int q = nwg / NXCD, r = nwg % NXCD, xcd = wgid % NXCD, off = wgid / NXCD; wgid = (xcd < r ? xcd * (q + 1) : r * (q + 1) + (xcd - r) * q) + off; }
        const int nig = WGM * nN, gid = wgid / nig, fm = gid * WGM, gsz = (nM - fm) < WGM ? (nM - fm) : WGM;
        u.pm = fm + ((wgid % nig) % gsz); u.pn = (wgid % nig) / gsz; return true;
    }
    __device__ __forceinline__ void a_ready(const Unit&) const {}
    __device__ __forceinline__ void done(const Unit&) const {}
};

__device__ __forceinline__ unsigned cvt_pk_bf16(float lo, float hi) { unsigned r; asm volatile("v_cvt_pk_bf16_f32 %0, %1, %2" : "=v"(r) : "v"(lo), "v"(hi)); return r; }
typedef float f32x2 __attribute__((ext_vector_type(2)));
template <class Epi, class Sched, bool ALIGN_EPI = false, bool SP2 = false>
__device__ __forceinline__ void gemm_phase(PG8_LAS unsigned char* lds, const Gemm g, const Sched& S, const Epi& E) {
    int tid_ = threadIdx.x; asm volatile("" : "+v"(tid_));
    const int tid = tid_, wid = __builtin_amdgcn_readfirstlane(tid >> 6), lane = tid & 63, wr = wid >> 2, wc = wid & 3, fr = lane & 15, fq = lane >> 4;
    const int K = g.K, nt = K / BK;
    unsigned voffA[2], voffB[2];
#pragma unroll
    for (int i = 0; i < 2; ++i) { int R, C; stage_rc(tid * 16 + i * 8192, R, C); const int Rb = Epi::PERM ? ((R & ~31) + perm32(R & 31)) : R;
        voffA[i] = (unsigned)(R * K + C) * 2u; voffB[i] = (unsigned)(Rb * K + C) * 2u; }
    const size_t kstep = (size_t)(BK * 2);
    const size_t hstep = (size_t)HALF * K * 2;
    const size_t tstep = 2 * hstep;
    const unsigned ldsw = (unsigned)wid * 1024u;
    const int aoff = lds_byte(wr * 64 + fr, fq * 8), boff = lds_byte(wc * 32 + fr, fq * 8);
#define PG8_SA(b, h) (((b) * 2 + (h)) * HTB)
#define PG8_SB(b, h) ((4 + (b) * 2 + (h)) * HTB)
#define PG8_STAGE(bufoff, gbase, voff) do { _Pragma("unroll") for (int _i = 0; _i < 2; ++_i) \
        __builtin_amdgcn_global_load_lds((const unsigned*)((const char*)(gbase) + (voff)[_i]), (PG8_LAS unsigned*)(lds + (bufoff) + ldsw + _i * 8192), 16, 0, 0); } while (0)
#define PG8_LDA(dst, b, h) do { _Pragma("unroll") for (int m = 0; m < 4; ++m) _Pragma("unroll") for (int k = 0; k < 2; ++k) dst[m][k] = *(const PG8_LAS bf16x8*)(lds + PG8_SA(b, h) + aoff + m * 2048 + k * 1024); } while (0)
#define PG8_LDB(dst, b, h) do { _Pragma("unroll") for (int n = 0; n < 2; ++n) _Pragma("unroll") for (int k = 0; k < 2; ++k) dst[n][k] = *(const PG8_LAS bf16x8*)(lds + PG8_SB(b, h) + boff + n * 2048 + k * 1024); } while (0)
#define PG8_MMA(ai, bj, At, Bt) do { __builtin_amdgcn_s_setprio(1); _Pragma("unroll") for (int m = 0; m < 4; ++m) _Pragma("unroll") for (int n = 0; n < 2; ++n) _Pragma("unroll") for (int k = 0; k < 2; ++k) \
        acc[ai][bj][m][n] = __builtin_amdgcn_mfma_f32_16x16x32_bf16(Bt[n][k], At[m][k], acc[ai][bj][m][n], 0, 0, 0); __builtin_amdgcn_s_setprio(0); } while (0)
#define PG8_WAIT_V(n) asm volatile("s_waitcnt vmcnt(" #n ")" ::: "memory")
#define PG8_WAIT_L(n) asm volatile("s_waitcnt lgkmcnt(" #n ")" ::: "memory")
#define PG8_BAR __builtin_amdgcn_s_barrier()
#define PG8_SCHED __builtin_amdgcn_sched_barrier(0)
    Unit cur, nxt; int ui = 0;
    if (!S.next(0, cur)) return;
    f32x4 acc[2][2][4][2];
#pragma unroll
    for (int a = 0; a < 2; ++a)
#pragma unroll
        for (int b = 0; b < 2; ++b)
#pragma unroll
            for (int m = 0; m < 4; ++m)
#pragma unroll
                for (int n = 0; n < 2; ++n) acc[a][b][m][n] = (f32x4){0.f, 0.f, 0.f, 0.f};
    bf16x8 At[4][2], B0[2][2], B1[2][2];
    const char* cA = (const char*)g.A + (size_t)cur.pm * tstep; const char* cB = (const char*)g.Bt + (size_t)cur.pn * tstep;
    S.a_ready(cur);
    if constexpr (SP2) {
        PG8_STAGE(PG8_SB(0, 0), cB, voffB); PG8_STAGE(PG8_SB(0, 1), cB + hstep, voffB); PG8_STAGE(PG8_SA(0, 0), cA, voffA); PG8_STAGE(PG8_SA(0, 1), cA + hstep, voffA);
        if (wr == 1) PG8_BAR;
        PG8_WAIT_V(2); PG8_BAR;
        PG8_STAGE(PG8_SB(1, 0), cB + kstep, voffB); PG8_STAGE(PG8_SA(1, 0), cA + kstep, voffA); PG8_STAGE(PG8_SB(1, 1), cB + hstep + kstep, voffB);
        PG8_WAIT_V(6); PG8_BAR;
    } else {
        PG8_STAGE(PG8_SB(0, 0), cB, voffB); PG8_STAGE(PG8_SA(0, 0), cA, voffA); PG8_STAGE(PG8_SB(0, 1), cB + hstep, voffB); PG8_STAGE(PG8_SA(0, 1), cA + hstep, voffA);
        if (wr == 1) PG8_BAR;
        PG8_WAIT_V(4); PG8_BAR;
        PG8_STAGE(PG8_SB(1, 0), cB + kstep, voffB); PG8_STAGE(PG8_SA(1, 0), cA + kstep, voffA); PG8_STAGE(PG8_SB(1, 1), cB + hstep + kstep, voffB);
        PG8_WAIT_V(6); PG8_BAR;
    }
    for (;;) {
        const bool has_next = S.next(ui + 1, nxt);
        const char* nA = has_next ? (const char*)g.A + (size_t)nxt.pm * tstep : cA; const char* nB = has_next ? (const char*)g.Bt + (size_t)nxt.pn * tstep : cB;
        for (int t = 0; t < nt; t += 2) {
            const bool last = (t == nt - 2);
            const char* a1 = cA + (size_t)(t + 1) * kstep;
            const char* a2 = last ? nA : cA + (size_t)(t + 2) * kstep; const char* b2 = last ? nB : cB + (size_t)(t + 2) * kstep;
            const char* a3 = a2 + kstep; const char* b3 = b2 + kstep;
            if (last && has_next) S.a_ready(nxt);
            if constexpr (SP2) {
            PG8_LDB(B0, 0, 0); PG8_LDB(B1, 0, 1); PG8_SCHED; PG8_LDA(At, 0, 0); PG8_STAGE(PG8_SA(1, 1), a1 + hstep, voffA);
            PG8_WAIT_V(8); PG8_WAIT_L(0); PG8_BAR; PG8_MMA(0, 0, At, B0); PG8_MMA(0, 1, At, B1); PG8_BAR; PG8_SCHED;
            PG8_LDA(At, 0, 1); PG8_STAGE(PG8_SB(0, 0), b2, voffB); PG8_STAGE(PG8_SB(0, 1), b2 + hstep, voffB); PG8_STAGE(PG8_SA(0, 0), a2, voffA);
            PG8_WAIT_V(8); PG8_WAIT_L(0); PG8_BAR; PG8_MMA(1, 0, At, B0); PG8_MMA(1, 1, At, B1); PG8_BAR; PG8_SCHED;
            PG8_LDB(B0, 1, 0); PG8_LDB(B1, 1, 1); PG8_SCHED; PG8_LDA(At, 1, 0); PG8_STAGE(PG8_SA(0, 1), a2 + hstep, voffA);
            PG8_WAIT_V(8); PG8_WAIT_L(0); PG8_BAR; PG8_MMA(0, 0, At, B0); PG8_MMA(0, 1, At, B1); PG8_BAR; PG8_SCHED;
            PG8_LDA(At, 1, 1); PG8_STAGE(PG8_SB(1, 0), b3, voffB); PG8_STAGE(PG8_SB(1, 1), b3 + hstep, voffB); PG8_STAGE(PG8_SA(1, 0), a3, voffA);
            PG8_WAIT_V(8); PG8_WAIT_L(0); PG8_BAR; PG8_MMA(1, 0, At, B0); PG8_MMA(1, 1, At, B1); PG8_BAR; PG8_SCHED;
            } else {
            PG8_LDB(B0, 0, 0); PG8_SCHED; PG8_LDA(At, 0, 0); PG8_STAGE(PG8_SA(1, 1), a1 + hstep, voffA);
            PG8_WAIT_L(8); PG8_BAR; PG8_WAIT_L(0); PG8_MMA(0, 0, At, B0); PG8_BAR; PG8_SCHED;
            PG8_LDB(B1, 0, 1); PG8_STAGE(PG8_SB(0, 0), b2, voffB);
            PG8_BAR; PG8_WAIT_L(0); PG8_MMA(0, 1, At, B1); PG8_BAR;
            PG8_LDA(At, 0, 1); PG8_STAGE(PG8_SA(0, 0), a2, voffA);
            PG8_BAR; PG8_WAIT_L(0); PG8_MMA(1, 0, At, B0); PG8_BAR; PG8_SCHED;
            PG8_STAGE(PG8_SB(0, 1), b2 + hstep, voffB);
            PG8_WAIT_V(6); PG8_BAR; PG8_MMA(1, 1, At, B1); PG8_BAR;
            PG8_LDB(B0, 1, 0); PG8_SCHED; PG8_LDA(At, 1, 0); PG8_STAGE(PG8_SA(0, 1), a2 + hstep, voffA);
            PG8_WAIT_L(8); PG8_BAR; PG8_WAIT_L(0); PG8_MMA(0, 0, At, B0); PG8_BAR; PG8_SCHED;
            PG8_LDB(B1, 1, 1); PG8_STAGE(PG8_SB(1, 0), b3, voffB);
            PG8_BAR; PG8_WAIT_L(0); PG8_MMA(0, 1, At, B1); PG8_BAR;
            PG8_LDA(At, 1, 1); PG8_STAGE(PG8_SA(1, 0), a3, voffA);
            PG8_BAR; PG8_WAIT_L(0); PG8_MMA(1, 0, At, B0); PG8_BAR; PG8_SCHED;
            PG8_STAGE(PG8_SB(1, 1), b3 + hstep, voffB);
            PG8_WAIT_V(6); PG8_BAR; PG8_MMA(1, 1, At, B1); PG8_BAR;
            }
        }
        if constexpr (ALIGN_EPI) { if (wr == 0) PG8_BAR; }
        if constexpr (!Epi::AFTER_DRAIN) { E(acc, cur, wr, wc, fr, fq); S.done(cur); }
        if (!has_next) break;
#pragma unroll
        for (int a = 0; a < 2; ++a)
#pragma unroll
            for (int b = 0; b < 2; ++b)
#pragma unroll
                for (int m = 0; m < 4; ++m)
#pragma unroll
                    for (int n = 0; n < 2; ++n) acc[a][b][m][n] = (f32x4){0.f, 0.f, 0.f, 0.f};
        cur = nxt; cA = nA; cB = nB; ++ui;
        if constexpr (ALIGN_EPI) { if (wr == 1) PG8_BAR; }
    }
    PG8_WAIT_V(0);
    if constexpr (!ALIGN_EPI) { if (wr == 0) PG8_BAR; }
    PG8_BAR;
    if constexpr (Epi::AFTER_DRAIN) { E.fused(acc, cur, wr, wc, fr, fq, lds, wid, lane); S.done(cur); }
#undef PG8_SA
#undef PG8_SB
#undef PG8_STAGE
#undef PG8_LDA
#undef PG8_LDB
#undef PG8_MMA
#undef PG8_WAIT_V
#undef PG8_WAIT_L
#undef PG8_BAR
#undef PG8_SCHED
}
}

#define LAS __attribute__((address_space(3)))
using pg8::bf16_t; using pg8::bf16x8; using pg8::f32x4; using pg8::u32x4; using pg8::Unit; using pg8::cvt_pk_bf16;
typedef unsigned u32x2 __attribute__((ext_vector_type(2)));

constexpr int D = 1024, FF = 2816, MP = 16384, MS = 256, MT = MP + MS, SEQ = 8192, NQKV = 2304, AW = 768;
constexpr int NWAVES = 8, NTHREADS = 512, LDS_MAIN = 139264, LDS_BYTES = LDS_MAIN + 16;
constexpr float NORM_EPS = 1e-6f;

constexpr size_t SZ_WGU = (size_t)2 * FF * D * 2, SZ_WD = (size_t)D * FF * 2;
constexpr size_t WS_WGU = 0;
constexpr size_t WS_WD = WS_WGU + 4 * SZ_WGU;
constexpr size_t WS_WQKV = WS_WD + 4 * SZ_WD;
constexpr size_t WS_WO = WS_WQKV + (size_t)NQKV * D * 2;
constexpr size_t WS_WIN = WS_WO + (size_t)D * AW * 2;
constexpr size_t WS_WGLU = WS_WIN + (size_t)D * D * 2;
constexpr size_t WS_WOUT = WS_WGLU + (size_t)D * D * 2;
constexpr size_t WS_XB = WS_WOUT + (size_t)D * D * 2;
constexpr size_t WS_XRES = WS_XB + (size_t)MT * D * 2;
constexpr size_t WS_R1 = WS_XRES + (size_t)MT * D * 4;
constexpr size_t WS_R2 = WS_R1 + (size_t)MT * FF * 2;
constexpr size_t R2_OG = 0, R2_OM = (size_t)MT * AW * 2, R2_LSE = 2 * (size_t)MT * AW * 2;
constexpr size_t R2_GB = 0, R2_ZB = (size_t)MT * D * 2;
constexpr size_t WS_SSQ = WS_R2 + 2 * (size_t)MT * D * 2;
constexpr size_t SZ_SSQ = (size_t)MT * 16 * 4;
constexpr size_t WS_CHS = WS_SSQ + 7 * SZ_SSQ;
constexpr size_t WS_LAM = WS_CHS + (size_t)2 * 64 * 64 * 64 * 2 * 4;
constexpr size_t WS_BB = WS_LAM + (size_t)64 * 64 * 4 * 4;
constexpr size_t WS_BAR = WS_BB + (size_t)64 * 64 * 32 * 4;
constexpr size_t WS_END = WS_BAR + 16384;

constexpr size_t O_Y = 0;
constexpr size_t O_KVP0 = (size_t)MT * D;
constexpr size_t O_KVP1 = O_KVP0 + (size_t)2 * 128 * 512;
constexpr size_t O_KVP2 = O_KVP1 + (size_t)2 * 512 * 512;
constexpr size_t O_SSMP = O_KVP2 + (size_t)2 * 2048 * 512;
constexpr size_t O_KVS0 = O_SSMP + (size_t)2 * 64 * 64 * 2;
constexpr size_t O_KVS1 = O_KVS0 + (size_t)32 * 128 * 512;
constexpr size_t O_KVS2 = O_KVS1 + (size_t)32 * 512 * 512;
constexpr size_t O_SSMS = O_KVS2 + (size_t)32 * 2048 * 512;
constexpr size_t O_END = O_SSMS + (size_t)32 * 64 * 64 * 2;

__device__ __forceinline__ float row_scale(const float* ssq, int row) {
    const f32x4* p = (const f32x4*)(ssq + (size_t)row * 16);
    const f32x4 a = p[0], b = p[1], c = p[2], d = p[3];
    const float s = (((a.x + a.y) + (a.z + a.w)) + ((b.x + b.y) + (b.z + b.w))) + (((c.x + c.y) + (c.z + c.w)) + ((d.x + d.y) + (d.z + d.w)));
    return rsqrtf(s * (1.0f / D) + NORM_EPS);
}
__device__ __forceinline__ float fast_sigmoid(float v) { return __builtin_amdgcn_rcpf(1.0f + __expf(-v)); }
__device__ __forceinline__ float bf2f(unsigned short b) { return __uint_as_float(((unsigned)b) << 16); }

__device__ __forceinline__ void row_scales8(const float* ssq, int row0, int fq, float (&s)[2][4]) {
#pragma unroll
    for (int ai = 0; ai < 2; ++ai) {
        f32x4 p[4];
#pragma unroll
        for (int m = 0; m < 4; ++m) p[m] = *(const f32x4*)(ssq + (size_t)(row0 + ai * 128 + m * 16) * 16 + 4 * fq);
#pragma unroll
        for (int m = 0; m < 4; ++m) { float t = (p[m][0] + p[m][1]) + (p[m][2] + p[m][3]); t += __shfl_xor(t, 16); t += __shfl_xor(t, 32); s[ai][m] = rsqrtf(t * (1.0f / D) + NORM_EPS); }
    }
}
struct EpiGU {
    static constexpr bool PERM = true, AFTER_DRAIN = false;
    const LAS float* rs; mutable int ui; bf16_t* act;
    __device__ __forceinline__ void operator()(const f32x4 (&acc)[2][2][4][2], const Unit& u, int wr, int wc, int fr, int fq) const {
        const int row0 = u.pm * 256 + wr * 64 + fr, col0 = u.pn * 128 + wc * 32 + 8 * fq;
        float sc[2][4];
        { const LAS float* t_ = rs + ui * 256 + wr * 64 + fr;
#pragma unroll
          for (int ai = 0; ai < 2; ++ai)
#pragma unroll
              for (int m = 0; m < 4; ++m) sc[ai][m] = t_[ai * 128 + m * 16];
          ++ui; }
#pragma unroll
        for (int ai = 0; ai < 2; ++ai)
#pragma unroll
            for (int m = 0; m < 4; ++m) {
                const int row = row0 + ai * 128 + m * 16; const float s = sc[ai][m];
                float a[8];
#pragma unroll
                for (int n = 0; n < 2; ++n) { const f32x4 g = acc[ai][0][m][n] * s, up = acc[ai][1][m][n] * s;
#pragma unroll
                    for (int j = 0; j < 4; ++j) a[4 * n + j] = g[j] * fast_sigmoid(g[j]) * up[j]; }
                u32x4 w; w.x = cvt_pk_bf16(a[0], a[1]); w.y = cvt_pk_bf16(a[2], a[3]); w.z = cvt_pk_bf16(a[4], a[5]); w.w = cvt_pk_bf16(a[6], a[7]);
                *(u32x4*)(act + (size_t)row * FF + col0) = w;
            }
    }
};
struct EpiRes {
    static constexpr bool PERM = true, AFTER_DRAIN = false;
    bf16_t* xb; float* ssq_out; float scale;
    __device__ __forceinline__ void operator()(const f32x4 (&acc)[2][2][4][2], const Unit& u, int wr, int wc, int fr, int fq) const {
        const int row0 = u.pm * 256 + wr * 64 + fr, col0 = u.pn * 256 + wc * 32 + 8 * fq;
        u32x4 r, nx; float q = 0.f;
        r = *(const u32x4*)(xb + (size_t)row0 * D + col0);
#pragma unroll
        for (int i = 0; i < 16; ++i) {
            const int ai = i >> 3, m = (i >> 1) & 3, bj = i & 1, row = row0 + ai * 128 + m * 16;
            if (i < 15) { const int i2 = i + 1; nx = *(const u32x4*)(xb + (size_t)(row0 + (i2 >> 3) * 128 + ((i2 >> 1) & 3) * 16) * D + col0 + (i2 & 1) * 128); }
            bf16_t* bp = xb + (size_t)row * D + col0 + bj * 128;
            f32x4 o0, o1;
            o0[0] = __uint_as_float(r.x << 16); o0[1] = __uint_as_float(r.x & 0xffff0000u); o0[2] = __uint_as_float(r.y << 16); o0[3] = __uint_as_float(r.y & 0xffff0000u);
            o1[0] = __uint_as_float(r.z << 16); o1[1] = __uint_as_float(r.z & 0xffff0000u); o1[2] = __uint_as_float(r.w << 16); o1[3] = __uint_as_float(r.w & 0xffff0000u);
            o0 += acc[ai][bj][m][0] * scale; o1 += acc[ai][bj][m][1] * scale;
            q += ((o0[0] * o0[0] + o0[1] * o0[1]) + (o0[2] * o0[2] + o0[3] * o0[3])) + ((o1[0] * o1[0] + o1[1] * o1[1]) + (o1[2] * o1[2] + o1[3] * o1[3]));
            u32x4 w; w.x = cvt_pk_bf16(o0[0], o0[1]); w.y = cvt_pk_bf16(o0[2], o0[3]); w.z = cvt_pk_bf16(o1[0], o1[1]); w.w = cvt_pk_bf16(o1[2], o1[3]);
            *(u32x4*)bp = w;
            if (bj == 1) { q += __shfl_xor(q, 16); q += __shfl_xor(q, 32); if (fq == 0) ssq_out[(size_t)row * 16 + u.pn * 4 + wc] = q; q = 0.f; }
            r = nx;
        }
    }
};
struct EpiQKV {
    static constexpr bool PERM = true, AFTER_DRAIN = false;
    const LAS float* rs; mutable int ui; bf16_t* qkvb; float* out;
    __device__ __forceinline__ void operator()(const f32x4 (&acc)[2][2][4][2], const Unit& u, int wr, int wc, int fr, int fq) const {
        const int row0 = u.pm * 256 + wr * 64 + fr, cl0 = wc * 32 + 8 * fq;
        const int c = u.pn / 3, g = u.pn - 3 * c, W = 128 << (2 * g);
        const size_t okp = g == 0 ? O_KVP0 : (g == 1 ? O_KVP1 : O_KVP2), oks = g == 0 ? O_KVS0 : (g == 1 ? O_KVS1 : O_KVS2);
        float sc[2][4];
        { const LAS float* t_ = rs + ui * 256 + wr * 64 + fr;
#pragma unroll
          for (int ai = 0; ai < 2; ++ai)
#pragma unroll
              for (int m = 0; m < 4; ++m) sc[ai][m] = t_[ai * 128 + m * 16];
          ++ui; }
#pragma unroll
        for (int ai = 0; ai < 2; ++ai)
#pragma unroll
            for (int m = 0; m < 4; ++m) {
                const int row = row0 + ai * 128 + m * 16; const float s = sc[ai][m];
                bf16_t* bp = qkvb + (size_t)row * NQKV + u.pn * 256 + cl0;
                float* kvp = nullptr;
                if (c > 0) {
                    if (row < MP) { const int b = row >> 13, t = row & (SEQ - 1); if (t >= SEQ - W) kvp = out + okp + ((size_t)(b * W + t - (SEQ - W)) * 2 + (c - 1)) * 256 + cl0; }
                    else { const int rs = row - MP, b = rs >> 3, t = rs & 7; kvp = out + oks + ((size_t)(b * W + W - 8 + t) * 2 + (c - 1)) * 256 + cl0; }
                }
#pragma unroll
                for (int bj = 0; bj < 2; ++bj) {
                    const f32x4 o0 = acc[ai][bj][m][0] * s, o1 = acc[ai][bj][m][1] * s;
                    u32x4 w; w.x = cvt_pk_bf16(o0[0], o0[1]); w.y = cvt_pk_bf16(o0[2], o0[3]); w.z = cvt_pk_bf16(o1[0], o1[1]); w.w = cvt_pk_bf16(o1[2], o1[3]);
                    *(u32x4*)(bp + bj * 128) = w;
                    if (kvp) { *(f32x4*)(kvp + bj * 128) = o0; *(f32x4*)(kvp + bj * 128 + 4) = o1; } }
            }
    }
};
struct EpiU {
    static constexpr bool PERM = true, AFTER_DRAIN = false;
    const LAS float* rs; mutable int ui; float* ubuf;
    __device__ __forceinline__ void operator()(const f32x4 (&acc)[2][2][4][2], const Unit& u, int wr, int wc, int fr, int fq) const {
        const int row0 = u.pm * 256 + wr * 64 + fr, col0 = u.pn * 256 + wc * 32 + 8 * fq;
        float sc[2][4];
        { const LAS float* t_ = rs + ui * 256 + wr * 64 + fr;
#pragma unroll
          for (int ai = 0; ai < 2; ++ai)
#pragma unroll
              for (int m = 0; m < 4; ++m) sc[ai][m] = t_[ai * 128 + m * 16];
          ++ui; }
#pragma unroll
        for (int ai = 0; ai < 2; ++ai)
#pragma unroll
            for (int m = 0; m < 4; ++m) {
                const int row = row0 + ai * 128 + m * 16; const float s = sc[ai][m];
                float* rp = ubuf + (size_t)row * D + col0;
#pragma unroll
                for (int bj = 0; bj < 2; ++bj) { *(f32x4*)(rp + bj * 128) = acc[ai][bj][m][0] * s; *(f32x4*)(rp + bj * 128 + 4) = acc[ai][bj][m][1] * s; }
            }
    }
};
struct EpiGLU {
    static constexpr bool PERM = true, AFTER_DRAIN = false;
    const bf16_t* gbuf; const float* bglu; bf16_t* zb;
    __device__ __forceinline__ void operator()(const f32x4 (&acc)[2][2][4][2], const Unit& u, int wr, int wc, int fr, int fq) const {
        const int row0 = u.pm * 256 + wr * 64 + fr, col0 = u.pn * 256 + wc * 32 + 8 * fq;
        f32x4 bv[2][2]; u32x4 gw[2], gn[2];
#pragma unroll
        for (int bj = 0; bj < 2; ++bj)
#pragma unroll
            for (int n = 0; n < 2; ++n) bv[bj][n] = *(const f32x4*)(bglu + col0 + bj * 128 + 4 * n);
#pragma unroll
        for (int bj = 0; bj < 2; ++bj) gw[bj] = *(const u32x4*)(gbuf + (size_t)row0 * D + col0 + bj * 128);
#pragma unroll
        for (int i = 0; i < 8; ++i) {
            const int ai = i >> 2, m = i & 3, row = row0 + ai * 128 + m * 16; bf16_t* zp = zb + (size_t)row * D + col0;
            if (i < 7) { const int i2 = i + 1;
#pragma unroll
                for (int bj = 0; bj < 2; ++bj) gn[bj] = *(const u32x4*)(gbuf + (size_t)(row0 + (i2 >> 2) * 128 + (i2 & 3) * 16) * D + col0 + bj * 128); }
#pragma unroll
            for (int bj = 0; bj < 2; ++bj) {
                const u32x4 g8 = gw[bj]; const f32x4 a0 = acc[ai][bj][m][0] + bv[bj][0], a1 = acc[ai][bj][m][1] + bv[bj][1];
                u32x4 w;
                w.x = cvt_pk_bf16(__uint_as_float(g8.x << 16) * fast_sigmoid(a0[0]), __uint_as_float(g8.x & 0xffff0000u) * fast_sigmoid(a0[1]));
                w.y = cvt_pk_bf16(__uint_as_float(g8.y << 16) * fast_sigmoid(a0[2]), __uint_as_float(g8.y & 0xffff0000u) * fast_sigmoid(a0[3]));
                w.z = cvt_pk_bf16(__uint_as_float(g8.z << 16) * fast_sigmoid(a1[0]), __uint_as_float(g8.z & 0xffff0000u) * fast_sigmoid(a1[1]));
                w.w = cvt_pk_bf16(__uint_as_float(g8.w << 16) * fast_sigmoid(a1[2]), __uint_as_float(g8.w & 0xffff0000u) * fast_sigmoid(a1[3]));
                *(u32x4*)(zp + bj * 128) = w; }
            gw[0] = gn[0]; gw[1] = gn[1];
        }
    }
};

template <class Epi> __device__ __forceinline__ void run_gemm(LAS unsigned char* lds, const bf16_t* A, const bf16_t* Bt, int N, int K, const Epi& E, int M = MT) {
    pg8::Gemm g; g.A = A; g.Bt = Bt; g.M = M; g.N = N; g.K = K;
    pg8::StaticOrder S; S.init(M, N, (int)gridDim.x, (int)blockIdx.x);
    pg8::gemm_phase<Epi, pg8::StaticOrder, true, true>(lds, g, S, E);
}

constexpr int RS_OFF = 131072;
__device__ __forceinline__ void rs_prepass(LAS unsigned char* lds, const float* ssq, int M, int N, int tid) {
    pg8::StaticOrder S; S.init(M, N, (int)gridDim.x, (int)blockIdx.x);
    LAS float* tab = (LAS float*)(lds + RS_OFF);
    int tq_ = tid; asm volatile("" : "+v"(tq_));
    const int r = tq_ & 255, h = tq_ >> 8;
    f32x4 p[4][4]; bool ok[4];
#pragma unroll
    for (int k = 0; k < 4; ++k) { Unit u; ok[k] = S.next(h + 2 * k, u);
        if (ok[k]) { const f32x4* q = (const f32x4*)(ssq + (size_t)(u.pm * 256 + r) * 16); p[k][0] = q[0]; p[k][1] = q[1]; p[k][2] = q[2]; p[k][3] = q[3]; } }
#pragma unroll
    for (int k = 0; k < 4; ++k) if (ok[k]) {
        const f32x4 a0 = p[k][0], b0 = p[k][1], c0 = p[k][2], d0 = p[k][3];
        const float t = (((a0[0] + a0[1]) + (a0[2] + a0[3])) + ((b0[0] + b0[1]) + (b0[2] + b0[3]))) + (((c0[0] + c0[1]) + (c0[2] + c0[3])) + ((d0[0] + d0[1]) + (d0[2] + d0[3])));
        tab[(h + 2 * k) * 256 + r] = rsqrtf(t * (1.0f / D) + NORM_EPS); }
    __syncthreads();
}

__device__ __forceinline__ float wave_sum(float v) {
#pragma unroll
    for (int o = 1; o < 64; o <<= 1) v += __shfl_xor(v, o);
    return v;
}
__device__ __forceinline__ float wave_max(float v) {
#pragma unroll
    for (int o = 1; o < 64; o <<= 1) v = fmaxf(v, __shfl_xor(v, o));
    return v;
}
__device__ __forceinline__ void p0_transpose_item(const float* W, int K, int N, bf16_t* WT, int mode, const float* gain, LAS float* scr, int item, int lane) {
    const int nblk = N / 32, kb = item / nblk, nb = item - kb * nblk, k0 = 64 * kb, n0 = 32 * nb;
#pragma unroll 16
    for (int i = 0; i < 32; ++i) { const int kk = 2 * i + (lane >> 5); float v = __builtin_nontemporal_load(W + (size_t)(k0 + kk) * N + n0 + (lane & 31)); if (gain) v *= gain[k0 + kk]; scr[kk * 33 + (lane & 31)] = v; }
    __builtin_amdgcn_s_waitcnt(0xC07F); asm volatile("" ::: "memory");
    const int c = lane & 7;
#pragma unroll
    for (int j = 0; j < 4; ++j) { const int nl = (lane >> 3) + 8 * j, n = n0 + nl; const LAS float* s = scr + (8 * c) * 33 + nl;
        u32x4 o; o.x = cvt_pk_bf16(s[0 * 33], s[1 * 33]); o.y = cvt_pk_bf16(s[2 * 33], s[3 * 33]); o.z = cvt_pk_bf16(s[4 * 33], s[5 * 33]); o.w = cvt_pk_bf16(s[6 * 33], s[7 * 33]);
        const int dr = mode == 0 ? n : (256 * (n >> 7) + (n & 127) + (mode == 2 ? 128 : 0));
        *(u32x4*)(WT + (size_t)dr * K + k0 + 8 * c) = o; }
    __builtin_amdgcn_s_waitcnt(0xC07F); asm volatile("" ::: "memory");
}

struct Args { const float* in[25]; float* out; unsigned char* ws; };

constexpr unsigned KV_PART = 18432u;
__host__ __device__ constexpr unsigned kv_tot(int g) { return 32u * ((128u << (2 * g)) - 8u) * 128u; }
__host__ __device__ constexpr unsigned kv_parts(int g) { return (kv_tot(g) + KV_PART - 1u) / KV_PART; }
__device__ __forceinline__ void kvg_copy(const Args& a, int g, unsigned lo, unsigned hi, unsigned t, unsigned nt) {
    const unsigned W = 128u << (2 * g), per_b = (W - 8u) * 128u;
    const f32x4* src = (const f32x4*)a.in[2 + g] + 8 * 128; f32x4* dst = (f32x4*)(a.out + (g == 0 ? O_KVS0 : (g == 1 ? O_KVS1 : O_KVS2)));
    for (unsigned i = lo + t; i < hi; i += 4u * nt) {
        f32x4 v[4]; unsigned off[4];
#pragma unroll
        for (int k = 0; k < 4; ++k) { const unsigned ii = i + (unsigned)k * nt; off[k] = 0xffffffffu;
            if (ii < hi) { const unsigned b = ii / per_b, r = ii - b * per_b; off[k] = b * W * 128u + r; v[k] = __builtin_nontemporal_load(src + off[k]); } }
#pragma unroll
        for (int k = 0; k < 4; ++k) if (off[k] != 0xffffffffu) __builtin_nontemporal_store(v[k], dst + off[k]);
    }
}
__device__ __forceinline__ void kv_slice(const Args& a, unsigned p, unsigned t) {
    int g; unsigned q;
    if (p < kv_parts(2)) { g = 2; q = p; } else if (p < kv_parts(2) + kv_parts(1)) { g = 1; q = p - kv_parts(2); } else if (p < kv_parts(2) + kv_parts(1) + kv_parts(0)) { g = 0; q = p - kv_parts(2) - kv_parts(1); } else return;
    const unsigned tot = 32u * ((128u << (2 * g)) - 8u) * 128u, lo = q * KV_PART, hi = lo + KV_PART < tot ? lo + KV_PART : tot;
    kvg_copy(a, g, lo, hi, t, NTHREADS);
}
__device__ __forceinline__ void p0_prologue(const Args& a, LAS unsigned char* lds, int wave, int lane) {
    unsigned char* ws = a.ws;
    LAS float* scr = (LAS float*)(lds + wave * 16384);
    const int gw = blockIdx.x * NWAVES + wave, NGW = gridDim.x * NWAVES;
    const float* norm_g = a.in[6];
    constexpr int I_GU = (D / 64) * (FF / 32), I_DN = (FF / 64) * (D / 32), I_QKV = (D / 64) * (NQKV / 32), I_O = (AW / 64) * (D / 32), I_SQ = (D / 64) * (D / 32);
    constexpr int NITEMS = 8 * I_GU + 4 * I_DN + I_QKV + I_O + 3 * I_SQ;
    for (int it = gw; it < NITEMS; it += NGW) {
        int r = it;
        if (r < 8 * I_GU) { const int w = r / I_GU, lf = w >> 1, isup = w & 1; r -= w * I_GU;
            const int layer = lf >> 1, f = lf & 1;
            p0_transpose_item((isup ? a.in[9] : a.in[8]) + (size_t)lf * D * FF, D, FF, (bf16_t*)(ws + WS_WGU + lf * SZ_WGU), isup ? 2 : 1, norm_g + (layer * 3 + (f ? 2 : 0)) * D, scr, r, lane); continue; }
        r -= 8 * I_GU;
        if (r < 4 * I_DN) { const int lf = r / I_DN; r -= lf * I_DN;
            p0_transpose_item(a.in[10] + (size_t)lf * FF * D, FF, D, (bf16_t*)(ws + WS_WD + lf * SZ_WD), 0, nullptr, scr, r, lane); continue; }
        r -= 4 * I_DN;
        if (r < I_QKV) { p0_transpose_item(a.in[11], D, NQKV, (bf16_t*)(ws + WS_WQKV), 0, norm_g + 1 * D, scr, r, lane); continue; }
        r -= I_QKV;
        if (r < I_O) { p0_transpose_item(a.in[12], AW, D, (bf16_t*)(ws + WS_WO), 0, nullptr, scr, r, lane); continue; }
        r -= I_O;
        if (r < I_SQ) { p0_transpose_item(a.in[13], D, D, (bf16_t*)(ws + WS_WIN), 0, norm_g + 4 * D, scr, r, lane); continue; }
        r -= I_SQ;
        if (r < I_SQ) { p0_transpose_item(a.in[22], D, D, (bf16_t*)(ws + WS_WGLU), 0, nullptr, scr, r, lane); continue; }
        r -= I_SQ;
        p0_transpose_item(a.in[24], D, D, (bf16_t*)(ws + WS_WOUT), 0, nullptr, scr, r, lane);
    }
    {
        bf16_t* xb = (bf16_t*)(ws + WS_XB); float* ssq0 = (float*)(ws + WS_SSQ);
        for (int row = gw; row < MT; row += NGW) {
            const float* src = row < MP ? a.in[0] + (size_t)row * D : a.in[1] + (size_t)(row - MP) * D;
            float s = 0.f;
#pragma unroll
            for (int j = 0; j < 4; ++j) {
                const f32x4 v = __builtin_nontemporal_load((const f32x4*)(src + 256 * j + 4 * lane));
                u32x2 w; w.x = cvt_pk_bf16(v[0], v[1]); w.y = cvt_pk_bf16(v[2], v[3]);
                *(u32x2*)(xb + (size_t)row * D + 256 * j + 4 * lane) = w;
                s += (v[0] * v[0] + v[1] * v[1]) + (v[2] * v[2] + v[3] * v[3]); }
            s = wave_sum(s);
            if (lane < 16) ssq0[(size_t)row * 16 + lane] = lane == 0 ? s : 0.f;
        }
    }
    {
        const size_t gt = (size_t)blockIdx.x * NTHREADS + threadIdx.x, NT = (size_t)gridDim.x * NTHREADS;
        const int G_ = (int)gridDim.x; const unsigned kv_nslots = (unsigned)(4 * (G_ - (65 * 22) % G_) + (G_ - (65 * 9) % G_));
#pragma unroll 1
        for (int g = 0; g < 3; ++g) {
            const int W = 128 << (2 * g); const unsigned per_b = (unsigned)(W - 8) * 128u, tot = 32u * per_b;
            const f32x4* src = (const f32x4*)a.in[2 + g]; f32x4* dst = (f32x4*)(a.out + (g == 0 ? O_KVS0 : (g == 1 ? O_KVS1 : O_KVS2)));
            const unsigned before = g == 2 ? 0u : (g == 1 ? kv_parts(2) : kv_parts(2) + kv_parts(1)), npg = g == 2 ? kv_parts(2) : (g == 1 ? kv_parts(1) : kv_parts(0));
            const unsigned cov = kv_nslots > before ? (kv_nslots - before < npg ? kv_nslots - before : npg) : 0u;
            const unsigned kv_start = cov * KV_PART < tot ? cov * KV_PART : tot;
            for (unsigned i = kv_start + (unsigned)gt; i < tot; i += 4u * (unsigned)NT) {
                f32x4 v[4]; unsigned off[4];
#pragma unroll
                for (int k = 0; k < 4; ++k) { const unsigned ii = i + (unsigned)k * (unsigned)NT; off[k] = 0xffffffffu;
                    if (ii < tot) { const unsigned b = ii / per_b, r = ii - b * per_b; off[k] = b * (unsigned)W * 128u + r; v[k] = __builtin_nontemporal_load(src + off[k] + 8 * 128); } }
#pragma unroll
                for (int k = 0; k < 4; ++k) if (off[k] != 0xffffffffu) __builtin_nontemporal_store(v[k], dst + off[k]);
            }
        }
        if (gt < 64 * 64) {
            const int g = (int)gt >> 6;
            const float are = a.in[14][gt], aim = a.in[15][gt], dt = expf(a.in[16][g]);
            const float mag = expf(are * dt), ang = aim * dt;
            float sn, cs; sincosf(ang, &sn, &cs);
            const float lre = mag * cs, lim = mag * sn, den = are * are + aim * aim, nre = lre - 1.0f;
            const float cre = (nre * are + lim * aim) / den, cim = (lim * are - nre * aim) / den;
            float pre = lre, pim = lim;
#pragma unroll
            for (int i = 0; i < 7; ++i) { const float t = pre * pre - pim * pim; pim = 2.f * pre * pim; pre = t; }
            float* lam = (float*)(ws + WS_LAM) + gt * 4; lam[0] = lre; lam[1] = lim; lam[2] = pre; lam[3] = pim;
            float* bb = (float*)(ws + WS_BB) + gt * 32; const float* bre = a.in[17] + gt * 16; const float* bim = a.in[18] + gt * 16;
#pragma unroll
            for (int c = 0; c < 16; ++c) { bb[c] = cre * bre[c] - cim * bim[c]; bb[16 + c] = cre * bim[c] + cim * bre[c]; }
        }
    }
}

constexpr int KL_PITCH = 72, VT_PITCH = 328, PW_PITCH = 168;
constexpr int ATT_KL = 0, ATT_VT = 256 * KL_PITCH * 2, ATT_PW = ATT_VT + 64 * VT_PITCH * 2, ATT_PW_WAVE = 16 * PW_PITCH * 2;
__device__ __forceinline__ void attn_prompt_item(LAS unsigned char* lds, const bf16_t* qkvb, bf16_t* og, float* lse, int it, int tid, int wave, int lane) {
    const int b = it / 768, rem0 = it - b * 768, g = rem0 >> 8, rem = rem0 & 255, hh = rem & 3, rq = rem >> 2;
    const int dl = 2 * g, dil = 1 << dl, r = rq & (dil - 1), qb = rq >> dl;
    const float slope = exp2f(-8.0f * (float)(g * 4 + hh + 1) / 12.0f);
    LAS bf16_t* Kl = (LAS bf16_t*)(lds + ATT_KL); LAS bf16_t* Vt = (LAS bf16_t*)(lds + ATT_VT); LAS bf16_t* Pw = (LAS bf16_t*)(lds + ATT_PW + wave * ATT_PW_WAVE);
    const int colk = AW + g * 256 + hh * 64;
#pragma unroll
    for (int pp = 0; pp < 4; ++pp) {
        const int p = tid + pp * NTHREADS, j = p >> 3, pc = p & 7, si = qb * 128 - 128 + j;
        u32x4 kv = (u32x4){0u, 0u, 0u, 0u}, vv = (u32x4){0u, 0u, 0u, 0u};
        if (si >= 0) { const bf16_t* kp = qkvb + (size_t)(b * SEQ + si * dil + r) * NQKV + colk + pc * 8; kv = *(const u32x4*)kp; vv = *(const u32x4*)(kp + AW); }
        *(LAS u32x4*)(Kl + j * KL_PITCH + pc * 8) = kv;
        LAS bf16_t* vd = Vt + (pc * 8) * VT_PITCH + ((((j >> 3) ^ pc) << 3) | (j & 7));
        vd[0 * VT_PITCH] = (bf16_t)(vv.x & 0xffffu); vd[1 * VT_PITCH] = (bf16_t)(vv.x >> 16); vd[2 * VT_PITCH] = (bf16_t)(vv.y & 0xffffu); vd[3 * VT_PITCH] = (bf16_t)(vv.y >> 16);
        vd[4 * VT_PITCH] = (bf16_t)(vv.z & 0xffffu); vd[5 * VT_PITCH] = (bf16_t)(vv.z >> 16); vd[6 * VT_PITCH] = (bf16_t)(vv.w & 0xffffu); vd[7 * VT_PITCH] = (bf16_t)(vv.w >> 16);
    }
    { const int d = tid >> 3, blk = 32 + (tid & 7); *(LAS u32x4*)(Vt + d * VT_PITCH + blk * 8) = (u32x4){0u, 0u, 0u, 0u}; }
    const int ql = lane & 15, fq = lane >> 4;
    const size_t qrow = (size_t)b * SEQ + (size_t)(qb * 128 + 16 * wave + ql) * dil + r;
    const bf16_t* qp = qkvb + qrow * NQKV + g * 256 + hh * 64;
    const bf16x8 q0 = *(const bf16x8*)(qp + 8 * fq), q1 = *(const bf16x8*)(qp + 32 + 8 * fq);
    __syncthreads();
    f32x4 sc[9]; float mx = -1e30f;
#pragma unroll
    for (int T = 0; T < 9; ++T) {
        const LAS bf16_t* kr = Kl + (16 * (wave + T) + ql) * KL_PITCH + 8 * fq;
        const bf16x8 a0 = *(const LAS bf16x8*)kr, a1 = *(const LAS bf16x8*)(kr + 32);
        f32x4 acc = (f32x4){0.f, 0.f, 0.f, 0.f};
        acc = __builtin_amdgcn_mfma_f32_16x16x32_bf16(a0, q0, acc, 0, 0, 0);
        acc = __builtin_amdgcn_mfma_f32_16x16x32_bf16(a1, q1, acc, 0, 0, 0);
#pragma unroll
        for (int j = 0; j < 4; ++j) {
            const int krel = 16 * T + 4 * fq + j, delta = 128 + ql - krel, ksub = qb * 128 - 128 + 16 * wave + krel;
            const bool valid = (delta >= 0) && (delta <= 128) && (ksub >= 0);
            const float s = valid ? acc[j] * 0.125f - slope * (float)(delta * dil) : -1e30f;
            acc[j] = s; mx = fmaxf(mx, s); }
        sc[T] = acc;
    }
    mx = fmaxf(mx, __shfl_xor(mx, 16)); mx = fmaxf(mx, __shfl_xor(mx, 32));
    float den = 0.f;
#pragma unroll
    for (int T = 0; T < 9; ++T) {
        f32x4 p;
#pragma unroll
        for (int j = 0; j < 4; ++j) { p[j] = sc[T][j] > -1e29f ? __expf(sc[T][j] - mx) : 0.f; den += p[j]; }
        u32x2 w; w.x = cvt_pk_bf16(p[0], p[1]); w.y = cvt_pk_bf16(p[2], p[3]);
        *(LAS u32x2*)(Pw + ql * PW_PITCH + 16 * T + 4 * fq) = w;
    }
    *(LAS u32x2*)(Pw + ql * PW_PITCH + 144 + 4 * fq) = (u32x2){0u, 0u};
    den += __shfl_xor(den, 16); den += __shfl_xor(den, 32);
    const float inv = 1.0f / den;
    __syncthreads();
    bf16_t* op = og + qrow * AW + g * 256 + hh * 64 + 4 * fq;
#pragma unroll
    for (int dt = 0; dt < 4; ++dt) {
        f32x4 o = (f32x4){0.f, 0.f, 0.f, 0.f};
#pragma unroll
        for (int ks = 0; ks < 5; ++ks) {
            const bf16x8 av = *(const LAS bf16x8*)(Vt + (16 * dt + ql) * VT_PITCH + (((2 * wave + 4 * ks + fq) ^ ((2 * dt + (ql >> 3)) & 7)) << 3));
            const bf16x8 bp = *(const LAS bf16x8*)(Pw + ql * PW_PITCH + 32 * ks + 8 * fq);
            o = __builtin_amdgcn_mfma_f32_16x16x32_bf16(av, bp, o, 0, 0, 0); }
        u32x2 w; w.x = cvt_pk_bf16(o[0] * inv, o[1] * inv); w.y = cvt_pk_bf16(o[2] * inv, o[3] * inv);
        *(u32x2*)(op + 16 * dt) = w;
    }
    if (fq == 0) lse[qrow * 12 + g * 4 + hh] = mx + __logf(den);
    __syncthreads();
}

__device__ __forceinline__ void attn_sample_item(const Args& a, const bf16_t* qkvb, bf16_t* og, float* lse, int it, int lane) {
    const int t = it & 7, hh = (it >> 3) & 3, bg = it >> 5, b = bg / 3, g = bg - 3 * b;
    const int W = 128 << (2 * g), dil = 1 << (2 * g);
    const float slope = exp2f(-8.0f * (float)(g * 4 + hh + 1) / 12.0f);
    const int row = MP + b * 8 + t;
    const float* cache = a.in[2 + g] + (size_t)b * W * 512 + hh * 64;
    const float* kvs = a.out + (g == 0 ? O_KVS0 : (g == 1 ? O_KVS1 : O_KVS2)) + (size_t)b * W * 512 + hh * 64;
    const bf16_t* qp = qkvb + (size_t)row * NQKV + g * 256 + hh * 64;
    float q[64];
#pragma unroll
    for (int i = 0; i < 8; ++i) { const u32x4 w = *(const u32x4*)(qp + 8 * i);
        q[8 * i + 0] = __uint_as_float(w.x << 16); q[8 * i + 1] = __uint_as_float(w.x & 0xffff0000u); q[8 * i + 2] = __uint_as_float(w.y << 16); q[8 * i + 3] = __uint_as_float(w.y & 0xffff0000u);
        q[8 * i + 4] = __uint_as_float(w.z << 16); q[8 * i + 5] = __uint_as_float(w.z & 0xffff0000u); q[8 * i + 6] = __uint_as_float(w.w << 16); q[8 * i + 7] = __uint_as_float(w.w & 0xffff0000u); }
    float sc[3];
#pragma unroll
    for (int pass = 0; pass < 3; ++pass) {
        const int j = lane + 64 * pass; const bool valid = j <= 128; const int jj = valid ? j : 128;
        const int idx = W + t - jj * dil;
        const float* kp = idx < W ? cache + (size_t)idx * 512 : kvs + (size_t)(idx - 8) * 512;
        float dot = 0.f;
#pragma unroll
        for (int i = 0; i < 16; ++i) { const f32x4 k4 = *(const f32x4*)(kp + 4 * i); dot += (q[4 * i] * k4[0] + q[4 * i + 1] * k4[1]) + (q[4 * i + 2] * k4[2] + q[4 * i + 3] * k4[3]); }
        sc[pass] = valid ? dot * 0.125f - slope * (float)(jj * dil) : -1e30f;
    }
    const float mx = wave_max(fmaxf(fmaxf(sc[0], sc[1]), sc[2]));
    float p[3];
#pragma unroll
    for (int pass = 0; pass < 3; ++pass) p[pass] = sc[pass] > -1e29f ? __expf(sc[pass] - mx) : 0.f;
    const float den = wave_sum(p[0] + p[1] + p[2]);
    float o = 0.f;
#pragma unroll 1
    for (int j0 = 0; j0 < 128; j0 += 32) {
        float v[32];
#pragma unroll
        for (int u = 0; u < 32; ++u) { const int idx = W + t - (j0 + u) * dil;
            const float* vp = (idx < W ? cache + (size_t)idx * 512 : kvs + (size_t)(idx - 8) * 512) + 256; v[u] = vp[lane]; }
        const float psrc = j0 < 64 ? p[0] : p[1];
#pragma unroll
        for (int u = 0; u < 32; ++u) o += __shfl(psrc, (j0 & 63) + u) * v[u];
    }
    o += __shfl(p[2], 0) * (cache + (size_t)t * 512 + 256)[lane];
    og[(size_t)row * AW + g * 256 + hh * 64 + lane] = (bf16_t)(cvt_pk_bf16(o / den, 0.f) & 0xffffu);
    if (lane == 0) lse[(size_t)row * 12 + g * 4 + hh] = mx + __logf(den);
}

__device__ __forceinline__ void merge_phase(const bf16_t* og, const float* lse, bf16_t* om) {
    const size_t gt = (size_t)blockIdx.x * NTHREADS + threadIdx.x, NT = (size_t)gridDim.x * NTHREADS, tot = (size_t)MT * 96;
    for (size_t i = gt; i < tot; i += NT) {
        const size_t row = i / 96; const int c8 = (int)(i - row * 96), col = c8 * 8, g = col >> 8, hh = (col & 255) >> 6;
        const float l0 = lse[row * 12 + hh], l1 = lse[row * 12 + 4 + hh], l2 = lse[row * 12 + 8 + hh];
        const float m = fmaxf(fmaxf(l0, l1), l2), e0 = __expf(l0 - m), e1 = __expf(l1 - m), e2 = __expf(l2 - m);
        const float al = (g == 0 ? e0 : (g == 1 ? e1 : e2)) / (e0 + e1 + e2);
        const u32x4 w = __builtin_nontemporal_load((const u32x4*)(og + row * AW + col)); u32x4 o;
        o.x = cvt_pk_bf16(__uint_as_float(w.x << 16) * al, __uint_as_float(w.x & 0xffff0000u) * al);
        o.y = cvt_pk_bf16(__uint_as_float(w.y << 16) * al, __uint_as_float(w.y & 0xffff0000u) * al);
        o.z = cvt_pk_bf16(__uint_as_float(w.z << 16) * al, __uint_as_float(w.z & 0xffff0000u) * al);
        o.w = cvt_pk_bf16(__uint_as_float(w.w << 16) * al, __uint_as_float(w.w & 0xffff0000u) * al);
        *(u32x4*)(om + row * AW + col) = o;
    }
}

constexpr int XB_PITCH = 136, BU_PITCH = 130, SC_CP = 68, SC_CRE = 0, SC_CIM = 16 * SC_CP * 4, SC_WAVE0 = 0, SC_UL = 0, SC_XRE = 4096, SC_BU = 4096 + 16 * XB_PITCH * 2, SC_WAVE = SC_BU + 16 * BU_PITCH * 4;
__device__ __forceinline__ float gelu_tanh(float x) {
    const float z = 0.7978845608028654f * (x + 0.044715f * x * x * x);
    const float th = 1.0f - 2.0f * __builtin_amdgcn_rcpf(__expf(2.0f * z) + 1.0f);
    return 0.5f * x * (1.0f + th);
}
typedef float f32x2v __attribute__((ext_vector_type(2)));
template <bool PROJECT>
__device__ __forceinline__ void scan_run(LAS unsigned char* lds, int wave, int lane, const float* ubuf, int row0, int ntok, int g, const float* lamp, const float* bbp, const float* dsk, const float* c_re, const float* c_im, bf16_t* gbuf, float& hre, float& him,
                                         bool reload, bf16x8 (&bop)[2][4], bf16x8 (&cop)[4], float& lre, float& lim, float& dv) {
    LAS unsigned char* wb = lds + SC_WAVE0 + wave * SC_WAVE;
    LAS float* Uh = (LAS float*)(wb + SC_UL); LAS bf16_t* Xb = (LAS bf16_t*)(wb + SC_XRE);
    LAS float* BUl = (LAS float*)(wb + SC_BU);
    const int c0 = 8 * ((lane >> 4) & 1), part = lane >> 5;
    const int c = lane & 15, tq = lane >> 4;
    if (reload) {
      lre = lamp[0]; lim = lamp[1];
      const float* bbg = bbp - (size_t)lane * 32;
#pragma unroll
      for (int i = 0; i < 4; ++i) { const float* bp = bbg + (size_t)(16 * i + (lane & 15)) * 32 + c0;
#pragma unroll
          for (int pr = 0; pr < 2; ++pr) { const f32x4 a0 = *(const f32x4*)(bp + 16 * pr), a1 = *(const f32x4*)(bp + 16 * pr + 4);
              u32x4 w; w.x = cvt_pk_bf16(a0[0], a0[1]); w.y = cvt_pk_bf16(a0[2], a0[3]); w.z = cvt_pk_bf16(a1[0], a1[1]); w.w = cvt_pk_bf16(a1[2], a1[3]);
              bop[pr][i] = __builtin_bit_cast(bf16x8, w); } }
      dv = PROJECT ? dsk[g * 16 + c] : 0.f;
    }
    if (PROJECT && reload) {
#pragma unroll
        for (int ks = 0; ks < 4; ++ks) { const size_t co = (size_t)(g * 16 + c) * 64 + 16 * ks + 4 * tq;
            const f32x4 a0 = *(const f32x4*)(c_re + co), a1 = *(const f32x4*)(c_im + co);
            u32x4 w; w.x = cvt_pk_bf16(a0[0], -a1[0]); w.y = cvt_pk_bf16(a0[1], -a1[1]); w.z = cvt_pk_bf16(a0[2], -a1[2]); w.w = cvt_pk_bf16(a0[3], -a1[3]);
            cop[ks] = __builtin_bit_cast(bf16x8, w); }
    }
    const int utt = lane >> 2, ucc = (lane & 3) * 4;
    f32x4 uh[4];
#pragma unroll
    for (int i = 0; i < 4; ++i) { uh[i] = (f32x4){0.f, 0.f, 0.f, 0.f}; if (16 * i + utt < ntok) uh[i] = *(const f32x4*)(ubuf + (size_t)(row0 + 16 * i + utt) * D + g * 16 + ucc); }
    const int nhalf = ntok > 64 ? 2 : 1;
#pragma unroll 1
    for (int half = 0; half < nhalf; ++half) {
#pragma unroll
    for (int i = 0; i < 4; ++i) *(LAS f32x4*)(Uh + (16 * i + utt) * 16 + ucc) = uh[i];
    if (half + 1 < nhalf) {
#pragma unroll
        for (int i = 0; i < 4; ++i) uh[i] = *(const f32x4*)(ubuf + (size_t)(row0 + 64 + 16 * i + utt) * D + g * 16 + ucc); }
    asm volatile("s_waitcnt lgkmcnt(0)" ::: "memory"); __builtin_amdgcn_wave_barrier();
#pragma unroll 1
    for (int tl = 0; tl < 4; ++tl) {
        const int t0 = 64 * half + 16 * tl; if (t0 >= ntok) break;
        const int nsub = (ntok - t0) < 16 ? (ntok - t0) : 16;
        LAS float* Ul = Uh + tl * 256;
        {
            const f32x4 a0 = *(const LAS f32x4*)(Ul + c * 16 + c0), a1 = *(const LAS f32x4*)(Ul + c * 16 + c0 + 4);
            u32x4 wh; wh.x = cvt_pk_bf16(a0[0], a0[1]); wh.y = cvt_pk_bf16(a0[2], a0[3]); wh.z = cvt_pk_bf16(a1[0], a1[1]); wh.w = cvt_pk_bf16(a1[2], a1[3]);
            u32x4 wl;
            wl.x = cvt_pk_bf16(a0[0] - __uint_as_float(wh.x << 16), a0[1] - __uint_as_float(wh.x & 0xffff0000u)); wl.y = cvt_pk_bf16(a0[2] - __uint_as_float(wh.y << 16), a0[3] - __uint_as_float(wh.y & 0xffff0000u));
            wl.z = cvt_pk_bf16(a1[0] - __uint_as_float(wh.z << 16), a1[1] - __uint_as_float(wh.z & 0xffff0000u)); wl.w = cvt_pk_bf16(a1[2] - __uint_as_float(wh.w << 16), a1[3] - __uint_as_float(wh.w & 0xffff0000u));
            u32x4 wsel; wsel.x = part ? wl.x : wh.x; wsel.y = part ? wl.y : wh.y; wsel.z = part ? wl.z : wh.z; wsel.w = part ? wl.w : wh.w;
            const bf16x8 aop = __builtin_bit_cast(bf16x8, wsel);
            f32x4 br[4], bi[4];
#pragma unroll
            for (int i = 0; i < 4; ++i) {
                f32x4 zr = (f32x4){0.f, 0.f, 0.f, 0.f}, zi = zr;
                br[i] = __builtin_amdgcn_mfma_f32_16x16x32_bf16(aop, bop[0][i], zr, 0, 0, 0); bi[i] = __builtin_amdgcn_mfma_f32_16x16x32_bf16(aop, bop[1][i], zi, 0, 0, 0);
            }
            asm volatile("s_nop 15\n\ts_nop 15\n\ts_nop 15\n\ts_nop 15" : "+v"(br[0]), "+v"(br[1]), "+v"(br[2]), "+v"(br[3]), "+v"(bi[0]), "+v"(bi[1]), "+v"(bi[2]), "+v"(bi[3]), "+v"(wsel));
#pragma unroll
            for (int i = 0; i < 4; ++i)
#pragma unroll
                for (int j = 0; j < 4; ++j) *(LAS f32x2v*)(BUl + (4 * tq + j) * BU_PITCH + 2 * (16 * i + c)) = (f32x2v){br[i][j], bi[i][j]};
            asm volatile("s_waitcnt lgkmcnt(0)" ::: "memory"); __builtin_amdgcn_wave_barrier();
        }
        {
            float bur[16], bui[16];
#pragma unroll
            for (int t = 0; t < 16; ++t) { const f32x2v bu = *(const LAS f32x2v*)(BUl + t * BU_PITCH + 2 * lane); bur[t] = bu.x; bui[t] = bu.y; }
#pragma unroll
            for (int t = 0; t < 16; ++t) {
                const float nre = lre * hre - lim * him + bur[t], nim = lre * him + lim * hre + bui[t];
                if (t < nsub) { hre = nre; him = nim; }
                if (PROJECT) *(LAS unsigned*)(Xb + t * XB_PITCH + 2 * lane) = cvt_pk_bf16(hre, him);
            }
        }
        if (PROJECT) {
            asm volatile("s_waitcnt lgkmcnt(0)" ::: "memory"); __builtin_amdgcn_wave_barrier();
            f32x4 y = (f32x4){0.f, 0.f, 0.f, 0.f};
#pragma unroll
            for (int ks = 0; ks < 4; ++ks) { const bf16x8 ax = *(const LAS bf16x8*)(Xb + c * XB_PITCH + 32 * ks + 8 * tq); y = __builtin_amdgcn_mfma_f32_16x16x32_bf16(ax, cop[ks], y, 0, 0, 0); }
#pragma unroll
            for (int i = 0; i < 4; ++i) { const int t = 4 * tq + i;
                if (t < nsub) { const float v = y[i] + dv * Ul[t * 16 + c];
                    gbuf[(size_t)(row0 + t0 + t) * D + g * 16 + c] = (bf16_t)(cvt_pk_bf16(gelu_tanh(v), 0.f) & 0xffffu); } }
            asm volatile("s_waitcnt lgkmcnt(0)" ::: "memory"); __builtin_amdgcn_wave_barrier();
        }
    }
    }
}
__device__ __forceinline__ void load_c(LAS unsigned char* lds, const float* cre, const float* cim, int g, int tid) {
    LAS float* Cre = (LAS float*)(lds + SC_CRE); LAS float* Cim = (LAS float*)(lds + SC_CIM);
    for (int e = tid; e < 1024; e += NTHREADS) { const int c = e >> 6, n = e & 63; Cre[c * SC_CP + n] = cre[g * 1024 + e]; Cim[c * SC_CP + n] = cim[g * 1024 + e]; }
}

struct SEpiRes {
    static constexpr bool HAS_SSQ = true;
    bf16_t* xb; float* ssq_out; float scale;
    __device__ __forceinline__ float apply(const f32x4 acc, int row, int col, int fq) const {
        bf16_t* bp = xb + (size_t)row * D + col; const u32x2 r = *(const u32x2*)bp; f32x4 o;
        o[0] = __uint_as_float(r.x << 16); o[1] = __uint_as_float(r.x & 0xffff0000u); o[2] = __uint_as_float(r.y << 16); o[3] = __uint_as_float(r.y & 0xffff0000u);
        o += acc * scale;
        u32x2 w; w.x = cvt_pk_bf16(o[0], o[1]); w.y = cvt_pk_bf16(o[2], o[3]); *(u32x2*)bp = w;
        return (o[0] * o[0] + o[1] * o[1]) + (o[2] * o[2] + o[3] * o[3]);
    }
};
struct SEpiU {
    static constexpr bool HAS_SSQ = false;
    const float* ssq; float* ubuf; float* ssq_out;
    __device__ __forceinline__ float apply(const f32x4 acc, int row, int col, int fq) const {
        const f32x4 p = *(const f32x4*)(ssq + (size_t)row * 16 + 4 * fq); float t = (p[0] + p[1]) + (p[2] + p[3]); t += __shfl_xor(t, 16); t += __shfl_xor(t, 32);
        const float sc = rsqrtf(t * (1.0f / D) + NORM_EPS);
        *(f32x4*)(ubuf + (size_t)row * D + col) = acc * sc; return 0.f;
    }
};
struct SEpiGLU {
    static constexpr bool HAS_SSQ = false;
    const bf16_t* gbuf; const float* bglu; bf16_t* zb; float* ssq_out;
    __device__ __forceinline__ float apply(const f32x4 acc, int row, int col, int fq) const {
        const u32x2 g4 = *(const u32x2*)(gbuf + (size_t)row * D + col); const f32x4 av = acc + *(const f32x4*)(bglu + col);
        u32x2 w; w.x = cvt_pk_bf16(__uint_as_float(g4.x << 16) * fast_sigmoid(av[0]), __uint_as_float(g4.x & 0xffff0000u) * fast_sigmoid(av[1]));
        w.y = cvt_pk_bf16(__uint_as_float(g4.y << 16) * fast_sigmoid(av[2]), __uint_as_float(g4.y & 0xffff0000u) * fast_sigmoid(av[3]));
        *(u32x2*)(zb + (size_t)row * D + col) = w; return 0.f;
    }
};
template <class SEpi>
__device__ __forceinline__ void sample_gemm(LAS unsigned char* lds, const bf16_t* A, const bf16_t* Bt, int K, const SEpi& E, int wave, int lane) {
    LAS f32x4* red = (LAS f32x4*)lds; LAS float* P = (LAS float*)(lds + 32768);
    const int fr = lane & 15, fq = lane >> 4, nks = K >> 8;
#pragma unroll 1
    for (int piece = blockIdx.x; piece < 256; piece += gridDim.x) {
        const int rt = piece >> 4, cg = piece & 15, row = MP + 16 * rt + fr;
        const bf16_t* ap = A + (size_t)row * K + wave * (K >> 3) + 8 * fq; const bf16_t* bp = Bt + (size_t)(64 * cg + fr) * K + wave * (K >> 3) + 8 * fq;
        f32x4 acc[4];
#pragma unroll
        for (int c = 0; c < 4; ++c) acc[c] = (f32x4){0.f, 0.f, 0.f, 0.f};
#pragma unroll 1
        for (int k0 = 0; k0 < nks; k0 += 4) {
            bf16x8 af[4], bf[4][4];
#pragma unroll
            for (int u = 0; u < 4; ++u) { const int ks = (k0 + u < nks) ? k0 + u : k0;
                af[u] = *(const bf16x8*)(ap + 32 * ks);
#pragma unroll
                for (int c = 0; c < 4; ++c) bf[u][c] = *(const bf16x8*)(bp + (size_t)(16 * c) * K + 32 * ks); }
#pragma unroll
            for (int u = 0; u < 4; ++u) if (k0 + u < nks) {
#pragma unroll
                for (int c = 0; c < 4; ++c) acc[c] = __builtin_amdgcn_mfma_f32_16x16x32_bf16(bf[u][c], af[u], acc[c], 0, 0, 0); }
        }
        asm volatile("s_nop 15\n\ts_nop 15" : "+v"(acc[0]), "+v"(acc[1]), "+v"(acc[2]), "+v"(acc[3]));
#pragma unroll
        for (int c = 0; c < 4; ++c) red[(wave * 4 + c) * 64 + lane] = acc[c];
        __syncthreads();
        if (wave < 4) {
            f32x4 t = red[wave * 64 + lane];
#pragma unroll
            for (int w = 1; w < 8; ++w) t += red[(w * 4 + wave) * 64 + lane];
            float q = E.apply(t, row, 64 * cg + 16 * wave + 4 * fq, fq);
            if (SEpi::HAS_SSQ) { q += __shfl_xor(q, 16); q += __shfl_xor(q, 32); if (fq == 0) P[wave * 16 + fr] = q; }
        }
        __syncthreads();
        if (SEpi::HAS_SSQ && wave == 0 && lane < 16) E.ssq_out[(size_t)(MP + 16 * rt + lane) * 16 + cg] = (P[lane] + P[16 + lane]) + (P[32 + lane] + P[48 + lane]);
        __syncthreads();
    }
}

#define XB_TMO      128
#define XB_XCNT(j)  (256  + 64 * (j))
#define XB_XSUB(j)  (1280 + 64 * (j))
#define XB_XGEN(j)  (2304 + 64 * (j))
#define XB_TOP      3328
#define XB_TOPGEN   3392
#define XCD_BAR_WORDS 3456
#define XB_SPIN_CAP (1u << 18)

__device__ __forceinline__ unsigned xb_ld(unsigned* p)              { return __hip_atomic_load(p, __ATOMIC_RELAXED, __HIP_MEMORY_SCOPE_AGENT); }
__device__ __forceinline__ unsigned xb_add(unsigned* p, unsigned v) { return __hip_atomic_fetch_add(p, v, __ATOMIC_RELAXED, __HIP_MEMORY_SCOPE_AGENT); }
__device__ __forceinline__ unsigned xb_xcc_id() { return (unsigned)__builtin_amdgcn_s_getreg((3 << 11) | 20) & 0xFu; }
#define XB_SPIN(cond, bar) do { unsigned _sp = 0; while (cond) { __builtin_amdgcn_s_sleep(1); \
    if ((++_sp & 255u) == 0u) { if (xb_ld(&(bar)[XB_TMO])) break; if (_sp > XB_SPIN_CAP) { atomicAdd(&(bar)[XB_TMO], 1u); break; } } } } while (0)

struct XcdBarrier {
    unsigned* bar; unsigned x;
    volatile LAS unsigned* st;
};

__device__ __forceinline__ XcdBarrier xcd_barrier_post(unsigned* bar, volatile LAS unsigned* st) {
    XcdBarrier b; b.bar = bar; b.x = xb_xcc_id(); b.st = st;
    if (threadIdx.x == 0) (void)xb_add(&bar[XB_XCNT(b.x)], 1u);
    return b;
}
__device__ __forceinline__ void xcd_barrier_complete(unsigned* bar, unsigned x, unsigned& nloc, unsigned& nx) {
    const unsigned G = gridDim.x * gridDim.y * gridDim.z;
    unsigned sum, cnt, mine, sp = 0u;
    for (;;) {
        sum = 0u; cnt = 0u; mine = 0u;
#pragma unroll
        for (unsigned j = 0; j < 16; ++j) { const unsigned c = xb_ld(&bar[XB_XCNT(j)]); sum += c; cnt += (c > 0u) ? 1u : 0u; mine = (j == x) ? c : mine; }
        if (sum == G) break;
        __builtin_amdgcn_s_sleep(1);
        if ((++sp & 255u) == 0u) { if (xb_ld(&bar[XB_TMO])) break; if (sp > XB_SPIN_CAP) { atomicAdd(&bar[XB_TMO], 1u); break; } }
    }
    nloc = mine > 0u ? mine : 1u; nx = cnt > 0u ? cnt : 1u;
}

__device__ __forceinline__ void xcd_barrier(const XcdBarrier& b) {
    asm volatile("s_waitcnt vmcnt(0)" ::: "memory");
    __syncthreads();
    if (threadIdx.x == 0) {
        unsigned* bar = b.bar;
        __builtin_amdgcn_s_waitcnt(0);
        unsigned nloc = b.st[0], nx = b.st[1];
        if (nloc == 0u) { xcd_barrier_complete(bar, b.x, nloc, nx); b.st[0] = nloc; b.st[1] = nx; }
        const unsigned old = xb_add(&bar[XB_XSUB(b.x)], 1u);
        const unsigned gen = old / nloc;
        if (old + 1u == (gen + 1u) * nloc) {
            __builtin_amdgcn_fence(__ATOMIC_RELEASE, "agent");
            asm volatile("s_waitcnt vmcnt(0)" ::: "memory");
            const unsigned og = xb_add(&bar[XB_TOP], 1u);
            const unsigned tg = og / nx;
            if (og + 1u == (tg + 1u) * nx) xb_add(&bar[XB_TOPGEN], 1u);
            else XB_SPIN(xb_ld(&bar[XB_TOPGEN]) == tg, bar);
            __builtin_amdgcn_fence(__ATOMIC_ACQUIRE, "agent");
            xb_add(&bar[XB_XGEN(b.x)], 1u);
            asm volatile("s_waitcnt vmcnt(0)" ::: "memory");
        } else {
            XB_SPIN(xb_ld(&bar[XB_XGEN(b.x)]) == gen, bar);
            __builtin_amdgcn_fence(__ATOMIC_ACQUIRE, "agent");
            asm volatile("s_waitcnt vmcnt(0)" ::: "memory");
        }
    }
    __syncthreads();
}


__global__ void __launch_bounds__(NTHREADS, 2) fwd_megakernel(Args a) {
    extern __shared__ __attribute__((aligned(16))) unsigned char lds_raw[];
    LAS unsigned char* lds = (LAS unsigned char*)lds_raw;
    cg::grid_group grid = cg::this_grid();
    const int tid = threadIdx.x, lane = tid & 63, wave = __builtin_amdgcn_readfirstlane(tid >> 6);
    volatile LAS unsigned* bar_st = (volatile LAS unsigned*)(lds + LDS_MAIN);
    if (tid == 0) { bar_st[0] = 0u; bar_st[1] = 0u; }
    __syncthreads();
    const XcdBarrier xbar = xcd_barrier_post((unsigned*)(a.ws + WS_BAR), bar_st);
#define GRID_BAR() xcd_barrier(xbar)
    unsigned char* ws = a.ws;
    bf16_t* xb = (bf16_t*)(ws + WS_XB);
    bf16_t* act = (bf16_t*)(ws + WS_R1); bf16_t* qkvb = (bf16_t*)(ws + WS_R1); float* ubuf = (float*)(ws + WS_R1);
    bf16_t* og = (bf16_t*)(ws + WS_R2 + R2_OG); bf16_t* om = (bf16_t*)(ws + WS_R2 + R2_OM); float* lse = (float*)(ws + WS_R2 + R2_LSE);
    bf16_t* gbuf = (bf16_t*)(ws + WS_R2 + R2_GB); bf16_t* zb = (bf16_t*)(ws + WS_R2 + R2_ZB);
    float* chs = (float*)(ws + WS_CHS); const float* lamb = (const float*)(ws + WS_LAM); const float* bbb = (const float*)(ws + WS_BB);
    const int kvg_first = (65 * 22) % (int)gridDim.x, kvg_n = (int)gridDim.x - kvg_first, kvq_first = (65 * 9) % (int)gridDim.x;
#define KVSLICE_AT(part) do { int tk_ = threadIdx.x; asm volatile("" : "+v"(tk_)); kv_slice(a, (unsigned)(part), (unsigned)tk_); } while (0)
#define KVSLICE(ph) do { if ((int)blockIdx.x >= kvg_first) KVSLICE_AT((ph) * kvg_n + ((int)blockIdx.x - kvg_first)); } while (0)
#define KVSLICE_Q() do { if ((int)blockIdx.x >= kvq_first) KVSLICE_AT(4 * kvg_n + ((int)blockIdx.x - kvq_first)); } while (0)
#define SSQ(i) ((float*)(ws + WS_SSQ + (size_t)(i) * SZ_SSQ))
#define WGU(i) ((const bf16_t*)(ws + WS_WGU + (size_t)(i) * SZ_WGU))
#define WDN(i) ((const bf16_t*)(ws + WS_WD + (size_t)(i) * SZ_WD))

    _Pragma("unroll") for (int rep = 0; rep < REP_P0; ++rep) { p0_prologue(a, lds, wave, lane); GRID_BAR(); }
    if (a.ws == nullptr) grid.sync();
    _Pragma("unroll") for (int rep = 0; rep < REP_GU; ++rep) { rs_prepass(lds, SSQ(0), MT, 2 * FF, tid); EpiGU E; E.rs = (const LAS float*)(lds + RS_OFF); E.ui = 0; E.act = act; run_gemm(lds, xb, WGU(0), 2 * FF, D, E); KVSLICE(0); GRID_BAR(); }
    { EpiRes E; E.xb = xb; E.ssq_out = SSQ(1); E.scale = 0.5f; run_gemm(lds, act, WDN(0), D, FF, E, MP);
      SEpiRes S; S.xb = xb; S.ssq_out = SSQ(1); S.scale = 0.5f; sample_gemm(lds, act, WDN(0), FF, S, wave, lane); }
    GRID_BAR();
    { rs_prepass(lds, SSQ(1), MT, NQKV, tid); EpiQKV E; E.rs = (const LAS float*)(lds + RS_OFF); E.ui = 0; E.qkvb = qkvb; E.out = a.out; run_gemm(lds, xb, (const bf16_t*)(ws + WS_WQKV), NQKV, D, E); KVSLICE_Q(); }
    GRID_BAR();
    _Pragma("unroll") for (int rep = 0; rep < REP_ATT; ++rep) {
#pragma unroll 1
        for (int it = blockIdx.x; it < 1536 * REP_ATTP; it += gridDim.x) attn_prompt_item(lds, qkvb, og, lse, it % 1536, tid, wave, lane);
#pragma unroll 1
        for (int it = blockIdx.x * NWAVES + wave; it < 32 * 3 * 4 * 8 * REP_ATTS; it += gridDim.x * NWAVES) attn_sample_item(a, qkvb, og, lse, it % 3072, lane);
        GRID_BAR();
    }
    _Pragma("unroll") for (int rep = 0; rep < REP_MERGE; ++rep) { merge_phase(og, lse, om); GRID_BAR(); }
    { EpiRes E; E.xb = xb; E.ssq_out = SSQ(2); E.scale = 1.0f; run_gemm(lds, om, (const bf16_t*)(ws + WS_WO), D, AW, E, MP);
      SEpiRes S; S.xb = xb; S.ssq_out = SSQ(2); S.scale = 1.0f; sample_gemm(lds, om, (const bf16_t*)(ws + WS_WO), AW, S, wave, lane); }
    GRID_BAR();
    { rs_prepass(lds, SSQ(2), MT, 2 * FF, tid); EpiGU E; E.rs = (const LAS float*)(lds + RS_OFF); E.ui = 0; E.act = act; run_gemm(lds, xb, WGU(1), 2 * FF, D, E); KVSLICE(1); }
    GRID_BAR();
    { EpiRes E; E.xb = xb; E.ssq_out = SSQ(3); E.scale = 0.5f; run_gemm(lds, act, WDN(1), D, FF, E, MP);
      SEpiRes S; S.xb = xb; S.ssq_out = SSQ(3); S.scale = 0.5f; sample_gemm(lds, act, WDN(1), FF, S, wave, lane); }
    GRID_BAR();
    { rs_prepass(lds, SSQ(3), MT, 2 * FF, tid); EpiGU E; E.rs = (const LAS float*)(lds + RS_OFF); E.ui = 0; E.act = act; run_gemm(lds, xb, WGU(2), 2 * FF, D, E); KVSLICE(2); }
    GRID_BAR();
    { EpiRes E; E.xb = xb; E.ssq_out = SSQ(4); E.scale = 0.5f; run_gemm(lds, act, WDN(2), D, FF, E, MP);
      SEpiRes S; S.xb = xb; S.ssq_out = SSQ(4); S.scale = 0.5f; sample_gemm(lds, act, WDN(2), FF, S, wave, lane); }
    GRID_BAR();
    { rs_prepass(lds, SSQ(4), MP, D, tid); EpiU E; E.rs = (const LAS float*)(lds + RS_OFF); E.ui = 0; E.ubuf = ubuf; run_gemm(lds, xb, (const bf16_t*)(ws + WS_WIN), D, D, E, MP);
      SEpiU S; S.ssq = SSQ(4); S.ubuf = ubuf; S.ssq_out = nullptr; sample_gemm(lds, xb, (const bf16_t*)(ws + WS_WIN), D, S, wave, lane); }
    GRID_BAR();
    _Pragma("unroll") for (int rep = 0; rep < REP_SCANA; ++rep) {
        bf16x8 bop[2][4], cop[4]; float lre = 0.f, lim = 0.f, dv = 0.f; int gcur = -1;
#pragma unroll 1
        for (int it = blockIdx.x; it < 1024; it += gridDim.x) {
            const int g = it & 63, cc = it >> 6, ccp = ((cc & 3) << 2) | (cc >> 2), b = ccp >> 3, co = ccp & 7, k = co * 8 + wave;
            float hre = 0.f, him = 0.f;
            scan_run<false>(lds, wave, lane, ubuf, b * SEQ + k * 128, 128, g, lamb + (g * 64 + lane) * 4, bbb + (g * 64 + lane) * 32, nullptr, nullptr, nullptr, nullptr, hre, him, g != gcur, bop, cop, lre, lim, dv);
            gcur = g;
            float* d = chs + ((((size_t)b * 64 + k) * 64 + g) * 64 + lane) * 2; d[0] = hre; d[1] = him;
        }
#pragma unroll 1
        for (int it = blockIdx.x; it < 256; it += gridDim.x) {
            const int bo = it & 3, g = it >> 2, b = bo * 8 + wave;
            const float* st = a.in[5] + (((size_t)b * 64 + g) * 64 + lane) * 2;
            float hre = st[0], him = st[1];
            scan_run<true>(lds, wave, lane, ubuf, MP + b * 8, 8, g, lamb + (g * 64 + lane) * 4, bbb + (g * 64 + lane) * 32, a.in[21], a.in[19], a.in[20], gbuf, hre, him, true, bop, cop, lre, lim, dv);
            float* d = a.out + O_SSMS + (((size_t)b * 64 + g) * 64 + lane) * 2; d[0] = hre; d[1] = him;
        }
        GRID_BAR();
    }
    _Pragma("unroll") for (int rep = 0; rep < REP_SCANC; ++rep) {
        bf16x8 bop[2][4], cop[4]; float lre = 0.f, lim = 0.f, dv = 0.f; int gcur = -1, bprev = -1, kprev = -100;
        float hre = 0.f, him = 0.f, pre = 0.f, pim = 0.f;
#pragma unroll 1
        for (int it = blockIdx.x; it < 1024; it += gridDim.x) {
            const int g = it & 63, cc = it >> 6, ccp = ((cc & 3) << 2) | (cc >> 2), b = ccp >> 3, co = ccp & 7, k = co * 8 + wave;
            const bool reload = g != gcur;
            if (reload) { const float* lp = lamb + (g * 64 + lane) * 4; pre = lp[2]; pim = lp[3]; }
            int jstart = 0;
            if (!reload && b == bprev && k == kprev + 8) jstart = kprev + 1;
            else { hre = 0.f; him = 0.f; }
#pragma unroll 1
            for (int j0 = jstart; j0 < k; j0 += 8) {
                float sr[8], si[8];
#pragma unroll
                for (int u = 0; u < 8; ++u) { const int j = (j0 + u < k) ? j0 + u : j0; const float* sp = chs + ((((size_t)b * 64 + j) * 64 + g) * 64 + lane) * 2; sr[u] = sp[0]; si[u] = sp[1]; }
#pragma unroll
                for (int u = 0; u < 8; ++u) if (j0 + u < k) { const float nre = pre * hre - pim * him + sr[u], nim = pre * him + pim * hre + si[u]; hre = nre; him = nim; }
            }
            scan_run<true>(lds, wave, lane, ubuf, b * SEQ + k * 128, 128, g, lamb + (g * 64 + lane) * 4, bbb + (g * 64 + lane) * 32, a.in[21], a.in[19], a.in[20], gbuf, hre, him, reload, bop, cop, lre, lim, dv);
            gcur = g; bprev = b; kprev = k;
            if (k == 63) { float* d = a.out + O_SSMP + (((size_t)b * 64 + g) * 64 + lane) * 2; d[0] = hre; d[1] = him; }
        }
        GRID_BAR();
    }
    { EpiGLU E; E.gbuf = gbuf; E.bglu = a.in[23]; E.zb = zb; run_gemm(lds, gbuf, (const bf16_t*)(ws + WS_WGLU), D, D, E, MP);
      SEpiGLU S; S.gbuf = gbuf; S.bglu = a.in[23]; S.zb = zb; S.ssq_out = nullptr; sample_gemm(lds, gbuf, (const bf16_t*)(ws + WS_WGLU), D, S, wave, lane); }
    GRID_BAR();
    { EpiRes E; E.xb = xb; E.ssq_out = SSQ(5); E.scale = 1.0f; run_gemm(lds, zb, (const bf16_t*)(ws + WS_WOUT), D, D, E, MP);
      SEpiRes S; S.xb = xb; S.ssq_out = SSQ(5); S.scale = 1.0f; sample_gemm(lds, zb, (const bf16_t*)(ws + WS_WOUT), D, S, wave, lane); }
    GRID_BAR();
    { rs_prepass(lds, SSQ(5), MT, 2 * FF, tid); EpiGU E; E.rs = (const LAS float*)(lds + RS_OFF); E.ui = 0; E.act = act; run_gemm(lds, xb, WGU(3), 2 * FF, D, E); KVSLICE(3); }
    GRID_BAR();
    { EpiRes E; E.xb = xb; E.ssq_out = SSQ(6); E.scale = 0.5f; run_gemm(lds, act, WDN(3), D, FF, E, MP);
      SEpiRes S; S.xb = xb; S.ssq_out = SSQ(6); S.scale = 0.5f; sample_gemm(lds, act, WDN(3), FF, S, wave, lane); }
    GRID_BAR();
    _Pragma("unroll") for (int rep = 0; rep < REP_FINAL; ++rep) {
        const float* gf = a.in[7]; const float* ssq6 = SSQ(6);
        for (int row = blockIdx.x * NWAVES + wave; row < MT; row += gridDim.x * NWAVES) {
            const float s = row_scale(ssq6, row);
#pragma unroll
            for (int j = 0; j < 2; ++j) { const int col = 512 * j + 8 * lane; const u32x4 r = __builtin_nontemporal_load((const u32x4*)(xb + (size_t)row * D + col));
                const f32x4 g0 = *(const f32x4*)(gf + col), g1 = *(const f32x4*)(gf + col + 4); f32x4 v0, v1;
                v0[0] = __uint_as_float(r.x << 16); v0[1] = __uint_as_float(r.x & 0xffff0000u); v0[2] = __uint_as_float(r.y << 16); v0[3] = __uint_as_float(r.y & 0xffff0000u);
                v1[0] = __uint_as_float(r.z << 16); v1[1] = __uint_as_float(r.z & 0xffff0000u); v1[2] = __uint_as_float(r.w << 16); v1[3] = __uint_as_float(r.w & 0xffff0000u);
                __builtin_nontemporal_store(v0 * s * g0, (f32x4*)(a.out + O_Y + (size_t)row * D + col)); __builtin_nontemporal_store(v1 * s * g1, (f32x4*)(a.out + O_Y + (size_t)row * D + col + 4)); }
        }
    }
}

extern "C" void kernel_launch(void* const* d_in, const int* in_sizes, int n_in, void* d_out, int out_size, void* d_ws, size_t ws_size, hipStream_t stream) {
    static int grid_blocks = 0;
    if (grid_blocks == 0) {
        if (n_in != 25 || (size_t)out_size != O_END || ws_size < WS_END) { fprintf(stderr, "kernel_launch: unexpected shapes: n_in %d out %d (want %zu) ws %zu (want >= %zu)\n", n_in, out_size, (size_t)O_END, ws_size, (size_t)WS_END); grid_blocks = -1; return; }
        int dev = 0, cus = 0, per_cu = 0;
        hipGetDevice(&dev); hipDeviceGetAttribute(&cus, hipDeviceAttributeMultiprocessorCount, dev);
        if (hipFuncSetAttribute((const void*)fwd_megakernel, hipFuncAttributeMaxDynamicSharedMemorySize, LDS_BYTES) != hipSuccess) { fprintf(stderr, "kernel_launch: hipFuncSetAttribute failed\n"); grid_blocks = -1; return; }
        if (hipOccupancyMaxActiveBlocksPerMultiprocessor(&per_cu, (const void*)fwd_megakernel, NTHREADS, LDS_BYTES) != hipSuccess || per_cu < 1) { fprintf(stderr, "kernel_launch: occupancy query failed (%d)\n", per_cu); grid_blocks = -1; return; }
        grid_blocks = cus * per_cu;
    }
    if (grid_blocks < 0) return;
    Args a{};
    for (int i = 0; i < 25; ++i) a.in[i] = (const float*)d_in[i];
    a.out = (float*)d_out; a.ws = (unsigned char*)d_ws;
    if (hipMemsetAsync((char*)d_ws + WS_BAR, 0, 16384, stream) != hipSuccess) { fprintf(stderr, "kernel_launch: hipMemsetAsync of the barrier words failed\n"); return; }
    void* args[] = {&a};
    hipError_t e = hipLaunchCooperativeKernel((const void*)fwd_megakernel, dim3(grid_blocks), dim3(NTHREADS), args, LDS_BYTES, stream);
    if (e != hipSuccess) fprintf(stderr, "cooperative launch failed: %s (grid %d)\n", hipGetErrorString(e), grid_blocks);
}
```

```cpp
#include <hip/hip_runtime.h>
#include <hip/hip_cooperative_groups.h>
#include <cstdio>
#include <cstdint>
namespace cg = cooperative_groups;
#define REP_P0 1
#define REP_ATT 1
#define REP_MERGE 1
#define REP_SCANA 1
#define REP_SCANC 1
#define REP_FINAL 1
#define REP_GU 1
#define REP_ATTP 1
#define REP_ATTS 1
namespace pg8 {
#define PG8_LAS __attribute__((address_space(3)))
typedef unsigned short bf16_t;
typedef short bf16x8 __attribute__((ext_vector_type(8)));
typedef float f32x4 __attribute__((ext_vector_type(4)));
typedef unsigned u32x4 __attribute__((ext_vector_type(4)));
constexpr int BM = 256, BK = 64, HALF = 128, HTB = HALF * BK * 2  , STAGE_BYTES = 8 * HTB, NXCD = 8, WGM = 8;

__host__ __device__ __forceinline__ int lds_byte(int r, int c) { const int st = (r >> 4) * 2 + (c >> 5), rr = r & 15, cc = c & 31, ob = rr * 64 + cc * 2; return st * 1024 + (ob ^ (((ob >> 9) & 1) << 5)); }
__host__ __device__ __forceinline__ void stage_rc(int b, int& R, int& C) { const int st = b / 1024, sb = b % 1024, swz = sb ^ (((sb >> 9) & 1) << 5); R = (st >> 1) * 16 + swz / 64; C = (st & 1) * 32 + (swz % 64) / 2; }
__host__ __device__ __forceinline__ int perm32(int rho) { const int n = rho >> 4, i = rho & 15; return 8 * (i >> 2) + 4 * n + (i & 3); }

struct Unit { int pm, pn; };
struct Gemm { const bf16_t* A; const bf16_t* Bt; int M, N, K; };

struct StaticOrder {
    int nM, nN, nwg, G, c;
    __host__ __device__ void init(int M, int N, int G_, int c_) { nM = M / BM; nN = N / BM; nwg = nM * nN; G = G_; c = c_; }
    __host__ __device__ bool next(int i, Unit& u) const {
        const long L = (long)i * G + c; if (L >= nwg) return false;
        int wgid = (int)L; { const int q = nwg / NXCD, r = nwg % NXCD, xcd = wgid % NXCD, off = wgid / NXCD; wgid = (xcd < r ? xcd * (q + 1) : r * (q + 1) + (xcd - r) * q) + off; }
        const int nig = WGM * nN, gid = wgid / nig, fm = gid * WGM, gsz = (nM - fm) < WGM ? (nM - fm) : WGM;
        u.pm = fm + ((wgid % nig) % gsz); u.pn = (wgid % nig) / gsz; return true;
    }
    __device__ __forceinline__ void a_ready(const Unit&) const {}
    __device__ __forceinline__ void done(const Unit&) const {}
};

__device__ __forceinline__ unsigned cvt_pk_bf16(float lo, float hi) { unsigned r; asm volatile("v_cvt_pk_bf16_f32 %0, %1, %2" : "=v"(r) : "v"(lo), "v"(hi)); return r; }
typedef float f32x2 __attribute__((ext_vector_type(2)));
template <class Epi, class Sched, bool ALIGN_EPI = false, bool SP2 = false>
__device__ __forceinline__ void gemm_phase(PG8_LAS unsigned char* lds, const Gemm g, const Sched& S, const Epi& E) {
    int tid_ = threadIdx.x; asm volatile("" : "+v"(tid_));
    const int tid = tid_, wid = __builtin_amdgcn_readfirstlane(tid >> 6), lane = tid & 63, wr = wid >> 2, wc = wid & 3, fr = lane & 15, fq = lane >> 4;
    const int K = g.K, nt = K / BK;
    unsigned voffA[2], voffB[2];
#pragma unroll
    for (int i = 0; i < 2; ++i) { int R, C; stage_rc(tid * 16 + i * 8192, R, C); const int Rb = Epi::PERM ? ((R & ~31) + perm32(R & 31)) : R;
        voffA[i] = (unsigned)(R * K + C) * 2u; voffB[i] = (unsigned)(Rb * K + C) * 2u; }
    const size_t kstep = (size_t)(BK * 2);
    const size_t hstep = (size_t)HALF * K * 2;
    const size_t tstep = 2 * hstep;
    const unsigned ldsw = (unsigned)wid * 1024u;
    const int aoff = lds_byte(wr * 64 + fr, fq * 8), boff = lds_byte(wc * 32 + fr, fq * 8);
#define PG8_SA(b, h) (((b) * 2 + (h)) * HTB)
#define PG8_SB(b, h) ((4 + (b) * 2 + (h)) * HTB)
#define PG8_STAGE(bufoff, gbase, voff) do { _Pragma("unroll") for (int _i = 0; _i < 2; ++_i) \
        __builtin_amdgcn_global_load_lds((const unsigned*)((const char*)(gbase) + (voff)[_i]), (PG8_LAS unsigned*)(lds + (bufoff) + ldsw + _i * 8192), 16, 0, 0); } while (0)
#define PG8_LDA(dst, b, h) do { _Pragma("unroll") for (int m = 0; m < 4; ++m) _Pragma("unroll") for (int k = 0; k < 2; ++k) dst[m][k] = *(const PG8_LAS bf16x8*)(lds + PG8_SA(b, h) + aoff + m * 2048 + k * 1024); } while (0)
#define PG8_LDB(dst, b, h) do { _Pragma("unroll") for (int n = 0; n < 2; ++n) _Pragma("unroll") for (int k = 0; k < 2; ++k) dst[n][k] = *(const PG8_LAS bf16x8*)(lds + PG8_SB(b, h) + boff + n * 2048 + k * 1024); } while (0)
#define PG8_MMA(ai, bj, At, Bt) do { __builtin_amdgcn_s_setprio(1); _Pragma("unroll") for (int m = 0; m < 4; ++m) _Pragma("unroll") for (int n = 0; n < 2; ++n) _Pragma("unroll") for (int k = 0; k < 2; ++k) \
        acc[ai][bj][m][n] = __builtin_amdgcn_mfma_f32_16x16x32_bf16(Bt[n][k], At[m][k], acc[ai][bj][m][n], 0, 0, 0); __builtin_amdgcn_s_setprio(0); } while (0)
#define PG8_WAIT_V(n) asm volatile("s_waitcnt vmcnt(" #n ")" ::: "memory")
#define PG8_WAIT_L(n) asm volatile("s_waitcnt lgkmcnt(" #n ")" ::: "memory")
#define PG8_BAR __builtin_amdgcn_s_barrier()
#define PG8_SCHED __builtin_amdgcn_sched_barrier(0)
    Unit cur, nxt; int ui = 0;
    if (!S.next(0, cur)) return;
    f32x4 acc[2][2][4][2];
#pragma unroll
    for (int a = 0; a < 2; ++a)
#pragma unroll
        for (int b = 0; b < 2; ++b)
#pragma unroll
            for (int m = 0; m < 4; ++m)
#pragma unroll
                for (int n = 0; n < 2; ++n) acc[a][b][m][n] = (f32x4){0.f, 0.f, 0.f, 0.f};
    bf16x8 At[4][2], B0[2][2], B1[2][2];
    const char* cA = (const char*)g.A + (size_t)cur.pm * tstep; const char* cB = (const char*)g.Bt + (size_t)cur.pn * tstep;
    S.a_ready(cur);
    if constexpr (SP2) {
        PG8_STAGE(PG8_SB(0, 0), cB, voffB); PG8_STAGE(PG8_SB(0, 1), cB + hstep, voffB); PG8_STAGE(PG8_SA(0, 0), cA, voffA); PG8_STAGE(PG8_SA(0, 1), cA + hstep, voffA);
        if (wr == 1) PG8_BAR;
        PG8_WAIT_V(2); PG8_BAR;
        PG8_STAGE(PG8_SB(1, 0), cB + kstep, voffB); PG8_STAGE(PG8_SA(1, 0), cA + kstep, voffA); PG8_STAGE(PG8_SB(1, 1), cB + hstep + kstep, voffB);
        PG8_WAIT_V(6); PG8_BAR;
    } else {
        PG8_STAGE(PG8_SB(0, 0), cB, voffB); PG8_STAGE(PG8_SA(0, 0), cA, voffA); PG8_STAGE(PG8_SB(0, 1), cB + hstep, voffB); PG8_STAGE(PG8_SA(0, 1), cA + hstep, voffA);
        if (wr == 1) PG8_BAR;
        PG8_WAIT_V(4); PG8_BAR;
        PG8_STAGE(PG8_SB(1, 0), cB + kstep, voffB); PG8_STAGE(PG8_SA(1, 0), cA + kstep, voffA); PG8_STAGE(PG8_SB(1, 1), cB + hstep + kstep, voffB);
        PG8_WAIT_V(6); PG8_BAR;
    }
    for (;;) {
        const bool has_next = S.next(ui + 1, nxt);
        const char* nA = has_next ? (const char*)g.A + (size_t)nxt.pm * tstep : cA; const char* nB = has_next ? (const char*)g.Bt + (size_t)nxt.pn * tstep : cB;
        for (int t = 0; t < nt; t += 2) {
            const bool last = (t == nt - 2);
            const char* a1 = cA + (size_t)(t + 1) * kstep;
            const char* a2 = last ? nA : cA + (size_t)(t + 2) * kstep; const char* b2 = last ? nB : cB + (size_t)(t + 2) * kstep;
            const char* a3 = a2 + kstep; const char* b3 = b2 + kstep;
            if (last && has_next) S.a_ready(nxt);
            if constexpr (SP2) {
            PG8_LDB(B0, 0, 0); PG8_LDB(B1, 0, 1); PG8_SCHED; PG8_LDA(At, 0, 0); PG8_STAGE(PG8_SA(1, 1), a1 + hstep, voffA);
            PG8_WAIT_V(8); PG8_WAIT_L(0); PG8_BAR; PG8_MMA(0, 0, At, B0); PG8_MMA(0, 1, At, B1); PG8_BAR; PG8_SCHED;
            PG8_LDA(At, 0, 1); PG8_STAGE(PG8_SB(0, 0), b2, voffB); PG8_STAGE(PG8_SB(0, 1), b2 + hstep, voffB); PG8_STAGE(PG8_SA(0, 0), a2, voffA);
            PG8_WAIT_V(8); PG8_WAIT_L(0); PG8_BAR; PG8_MMA(1, 0, At, B0); PG8_MMA(1, 1, At, B1); PG8_BAR; PG8_SCHED;
            PG8_LDB(B0, 1, 0); PG8_LDB(B1, 1, 1); PG8_SCHED; PG8_LDA(At, 1, 0); PG8_STAGE(PG8_SA(0, 1), a2 + hstep, voffA);
            PG8_WAIT_V(8); PG8_WAIT_L(0); PG8_BAR; PG8_MMA(0, 0, At, B0); PG8_MMA(0, 1, At, B1); PG8_BAR; PG8_SCHED;
            PG8_LDA(At, 1, 1); PG8_STAGE(PG8_SB(1, 0), b3, voffB); PG8_STAGE(PG8_SB(1, 1), b3 + hstep, voffB); PG8_STAGE(PG8_SA(1, 0), a3, voffA);
            PG8_WAIT_V(8); PG8_WAIT_L(0); PG8_BAR; PG8_MMA(1, 0, At, B0); PG8_MMA(1, 1, At, B1); PG8_BAR; PG8_SCHED;
            } else {
            PG8_LDB(B0, 0, 0); PG8_SCHED; PG8_LDA(At, 0, 0); PG8_STAGE(PG8_SA(1, 1), a1 + hstep, voffA);
            PG8_WAIT_L(8); PG8_BAR; PG8_WAIT_L(0); PG8_MMA(0, 0, At, B0); PG8_BAR; PG8_SCHED;
            PG8_LDB(B1, 0, 1); PG8_STAGE(PG8_SB(0, 0), b2, voffB);
            PG8_BAR; PG8_WAIT_L(0); PG8_MMA(0, 1, At, B1); PG8_BAR;
            PG8_LDA(At, 0, 1); PG8_STAGE(PG8_SA(0, 0), a2, voffA);
            PG8_BAR; PG8_WAIT_L(0); PG8_MMA(1, 0, At, B0); PG8_BAR; PG8_SCHED;
            PG8_STAGE(PG8_SB(0, 1), b2 + hstep, voffB);
            PG8_WAIT_V(6); PG8_BAR; PG8_MMA(1, 1, At, B1); PG8_BAR;
            PG8_LDB(B0, 1, 0); PG8_SCHED; PG8_LDA(At, 1, 0); PG8_STAGE(PG8_SA(0, 1), a2 + hstep, voffA);
            PG8_WAIT_L(8); PG8_BAR; PG8_WAIT_L(0); PG8_MMA(0, 0, At, B0); PG8_BAR; PG8_SCHED;
            PG8_LDB(B1, 1, 1); PG8_STAGE(PG8_SB(1, 0), b3, voffB);
            PG8_BAR; PG8_WAIT_L(0); PG8_MMA(0, 1, At, B1); PG8_BAR;
            PG8_LDA(At, 1, 1); PG8_STAGE(PG8_SA(1, 0), a3, voffA);
            PG8_BAR; PG8_WAIT_L(0); PG8_MMA(1, 0, At, B0); PG8_BAR; PG8_SCHED;
            PG8_STAGE(PG8_SB(1, 1), b3 + hstep, voffB);
            PG8_WAIT_V(6); PG8_BAR; PG8_MMA(1, 1, At, B1); PG8_BAR;
            }
        }
        if constexpr (ALIGN_EPI) { if (wr == 0) PG8_BAR; }
        if constexpr (!Epi::AFTER_DRAIN) { E(acc, cur, wr, wc, fr, fq); S.done(cur); }
        if (!has_next) break;
#pragma unroll
        for (int a = 0; a < 2; ++a)
#pragma unroll
            for (int b = 0; b < 2; ++b)
#pragma unroll
                for (int m = 0; m < 4; ++m)
#pragma unroll
                    for (int n = 0; n < 2; ++n) acc[a][b][m][n] = (f32x4){0.f, 0.f, 0.f, 0.f};
        cur = nxt; cA = nA; cB = nB; ++ui;
        if constexpr (ALIGN_EPI) { if (wr == 1) PG8_BAR; }
    }
    PG8_WAIT_V(0);
    if constexpr (!ALIGN_EPI) { if (wr == 0) PG8_BAR; }
    PG8_BAR;
    if constexpr (Epi::AFTER_DRAIN) { E.fused(acc, cur, wr, wc, fr, fq, lds, wid, lane); S.done(cur); }
#undef PG8_SA
#undef PG8_SB
#undef PG8_STAGE
#undef PG8_LDA
#undef PG8_LDB
#undef PG8_MMA
#undef PG8_WAIT_V
#undef PG8_WAIT_L
#undef PG8_BAR
#undef PG8_SCHED
}
}

#define LAS __attribute__((address_space(3)))
using pg8::bf16_t; using pg8::bf16x8; using pg8::f32x4; using pg8::u32x4; using pg8::Unit; using pg8::cvt_pk_bf16;
typedef unsigned u32x2 __attribute__((ext_vector_type(2)));

constexpr int D = 1024, FF = 2816, MP = 16384, MS = 256, MT = MP + MS, SEQ = 8192, NQKV = 2304, AW = 768;
constexpr int NWAVES = 8, NTHREADS = 512, LDS_MAIN = 139264, LDS_BYTES = LDS_MAIN + 16;
constexpr float NORM_EPS = 1e-6f;

constexpr size_t SZ_WGU = (size_t)2 * FF * D * 2, SZ_WD = (size_t)D * FF * 2;
constexpr size_t WS_WGU = 0;
constexpr size_t WS_WD = WS_WGU + 4 * SZ_WGU;
constexpr size_t WS_WQKV = WS_WD + 4 * SZ_WD;
constexpr size_t WS_WO = WS_WQKV + (size_t)NQKV * D * 2;
constexpr size_t WS_WIN = WS_WO + (size_t)D * AW * 2;
constexpr size_t WS_WGLU = WS_WIN + (size_t)D * D * 2;
constexpr size_t WS_WOUT = WS_WGLU + (size_t)D * D * 2;
constexpr size_t WS_XB = WS_WOUT + (size_t)D * D * 2;
constexpr size_t WS_XRES = WS_XB + (size_t)MT * D * 2;
constexpr size_t WS_R1 = WS_XRES + (size_t)MT * D * 4;
constexpr size_t WS_R2 = WS_R1 + (size_t)MT * FF * 2;
constexpr size_t R2_OG = 0, R2_OM = (size_t)MT * AW * 2, R2_LSE = 2 * (size_t)MT * AW * 2;
constexpr size_t R2_GB = 0, R2_ZB = (size_t)MT * D * 2;
constexpr size_t WS_SSQ = WS_R2 + 2 * (size_t)MT * D * 2;
constexpr size_t SZ_SSQ = (size_t)MT * 16 * 4;
constexpr size_t WS_CHS = WS_SSQ + 7 * SZ_SSQ;
constexpr size_t WS_LAM = WS_CHS + (size_t)2 * 64 * 64 * 64 * 2 * 4;
constexpr size_t WS_BB = WS_LAM + (size_t)64 * 64 * 4 * 4;
constexpr size_t WS_BAR = WS_BB + (size_t)64 * 64 * 32 * 4;
constexpr size_t WS_END = WS_BAR + 16384;

constexpr size_t O_Y = 0;
constexpr size_t O_KVP0 = (size_t)MT * D;
constexpr size_t O_KVP1 = O_KVP0 + (size_t)2 * 128 * 512;
constexpr size_t O_KVP2 = O_KVP1 + (size_t)2 * 512 * 512;
constexpr size_t O_SSMP = O_KVP2 + (size_t)2 * 2048 * 512;
constexpr size_t O_KVS0 = O_SSMP + (size_t)2 * 64 * 64 * 2;
constexpr size_t O_KVS1 = O_KVS0 + (size_t)32 * 128 * 512;
constexpr size_t O_KVS2 = O_KVS1 + (size_t)32 * 512 * 512;
constexpr size_t O_SSMS = O_KVS2 + (size_t)32 * 2048 * 512;
constexpr size_t O_END = O_SSMS + (size_t)32 * 64 * 64 * 2;

__device__ __forceinline__ float row_scale(const float* ssq, int row) {
    const f32x4* p = (const f32x4*)(ssq + (size_t)row * 16);
    const f32x4 a = p[0], b = p[1], c = p[2], d = p[3];
    const float s = (((a.x + a.y) + (a.z + a.w)) + ((b.x + b.y) + (b.z + b.w))) + (((c.x + c.y) + (c.z + c.w)) + ((d.x + d.y) + (d.z + d.w)));
    return rsqrtf(s * (1.0f / D) + NORM_EPS);
}
__device__ __forceinline__ float fast_sigmoid(float v) { return __builtin_amdgcn_rcpf(1.0f + __expf(-v)); }
__device__ __forceinline__ float bf2f(unsigned short b) { return __uint_as_float(((unsigned)b) << 16); }

__device__ __forceinline__ void row_scales8(const float* ssq, int row0, int fq, float (&s)[2][4]) {
#pragma unroll
    for (int ai = 0; ai < 2; ++ai) {
        f32x4 p[4];
#pragma unroll
        for (int m = 0; m < 4; ++m) p[m] = *(const f32x4*)(ssq + (size_t)(row0 + ai * 128 + m * 16) * 16 + 4 * fq);
#pragma unroll
        for (int m = 0; m < 4; ++m) { float t = (p[m][0] + p[m][1]) + (p[m][2] + p[m][3]); t += __shfl_xor(t, 16); t += __shfl_xor(t, 32); s[ai][m] = rsqrtf(t * (1.0f / D) + NORM_EPS); }
    }
}
struct EpiGU {
    static constexpr bool PERM = true, AFTER_DRAIN = false;
    const LAS float* rs; mutable int ui; bf16_t* act;
    __device__ __forceinline__ void operator()(const f32x4 (&acc)[2][2][4][2], const Unit& u, int wr, int wc, int fr, int fq) const {
        const int row0 = u.pm * 256 + wr * 64 + fr, col0 = u.pn * 128 + wc * 32 + 8 * fq;
        float sc[2][4];
        { const LAS float* t_ = rs + ui * 256 + wr * 64 + fr;
#pragma unroll
          for (int ai = 0; ai < 2; ++ai)
#pragma unroll
              for (int m = 0; m < 4; ++m) sc[ai][m] = t_[ai * 128 + m * 16];
          ++ui; }
#pragma unroll
        for (int ai = 0; ai < 2; ++ai)
#pragma unroll
            for (int m = 0; m < 4; ++m) {
                const int row = row0 + ai * 128 + m * 16; const float s = sc[ai][m];
                float a[8];
#pragma unroll
                for (int n = 0; n < 2; ++n) { const f32x4 g = acc[ai][0][m][n] * s, up = acc[ai][1][m][n] * s;
#pragma unroll
                    for (int j = 0; j < 4; ++j) a[4 * n + j] = g[j] * fast_sigmoid(g[j]) * up[j]; }
                u32x4 w; w.x = cvt_pk_bf16(a[0], a[1]); w.y = cvt_pk_bf16(a[2], a[3]); w.z = cvt_pk_bf16(a[4], a[5]); w.w = cvt_pk_bf16(a[6], a[7]);
                *(u32x4*)(act + (size_t)row * FF + col0) = w;
            }
    }
};
struct EpiRes {
    static constexpr bool PERM = true, AFTER_DRAIN = false;
    bf16_t* xb; float* ssq_out; float scale;
    __device__ __forceinline__ void operator()(const f32x4 (&acc)[2][2][4][2], const Unit& u, int wr, int wc, int fr, int fq) const {
        const int row0 = u.pm * 256 + wr * 64 + fr, col0 = u.pn * 256 + wc * 32 + 8 * fq;
        u32x4 r, nx; float q = 0.f;
        r = *(const u32x4*)(xb + (size_t)row0 * D + col0);
#pragma unroll
        for (int i = 0; i < 16; ++i) {
            const int ai = i >> 3, m = (i >> 1) & 3, bj = i & 1, row = row0 + ai * 128 + m * 16;
            if (i < 15) { const int i2 = i + 1; nx = *(const u32x4*)(xb + (size_t)(row0 + (i2 >> 3) * 128 + ((i2 >> 1) & 3) * 16) * D + col0 + (i2 & 1) * 128); }
            bf16_t* bp = xb + (size_t)row * D + col0 + bj * 128;
            f32x4 o0, o1;
            o0[0] = __uint_as_float(r.x << 16); o0[1] = __uint_as_float(r.x & 0xffff0000u); o0[2] = __uint_as_float(r.y << 16); o0[3] = __uint_as_float(r.y & 0xffff0000u);
            o1[0] = __uint_as_float(r.z << 16); o1[1] = __uint_as_float(r.z & 0xffff0000u); o1[2] = __uint_as_float(r.w << 16); o1[3] = __uint_as_float(r.w & 0xffff0000u);
            o0 += acc[ai][bj][m][0] * scale; o1 += acc[ai][bj][m][1] * scale;
            q += ((o0[0] * o0[0] + o0[1] * o0[1]) + (o0[2] * o0[2] + o0[3] * o0[3])) + ((o1[0] * o1[0] + o1[1] * o1[1]) + (o1[2] * o1[2] + o1[3] * o1[3]));
            u32x4 w; w.x = cvt_pk_bf16(o0[0], o0[1]); w.y = cvt_pk_bf16(o0[2], o0[3]); w.z = cvt_pk_bf16(o1[0], o1[1]); w.w = cvt_pk_bf16(o1[2], o1[3]);
            *(u32x4*)bp = w;
            if (bj == 1) { q += __shfl_xor(q, 16); q += __shfl_xor(q, 32); if (fq == 0) ssq_out[(size_t)row * 16 + u.pn * 4 + wc] = q; q = 0.f; }
            r = nx;
        }
    }
};
struct EpiQKV {
    static constexpr bool PERM = true, AFTER_DRAIN = false;
    const LAS float* rs; mutable int ui; bf16_t* qkvb; float* out;
    __device__ __forceinline__ void operator()(const f32x4 (&acc)[2][2][4][2], const Unit& u, int wr, int wc, int fr, int fq) const {
        const int row0 = u.pm * 256 + wr * 64 + fr, cl0 = wc * 32 + 8 * fq;
        const int c = u.pn / 3, g = u.pn - 3 * c, W = 128 << (2 * g);
        const size_t okp = g == 0 ? O_KVP0 : (g == 1 ? O_KVP1 : O_KVP2), oks = g == 0 ? O_KVS0 : (g == 1 ? O_KVS1 : O_KVS2);
        float sc[2][4];
        { const LAS float* t_ = rs + ui * 256 + wr * 64 + fr;
#pragma unroll
          for (int ai = 0; ai < 2; ++ai)
#pragma unroll
              for (int m = 0; m < 4; ++m) sc[ai][m] = t_[ai * 128 + m * 16];
          ++ui; }
#pragma unroll
        for (int ai = 0; ai < 2; ++ai)
#pragma unroll
            for (int m = 0; m < 4; ++m) {
                const int row = row0 + ai * 128 + m * 16; const float s = sc[ai][m];
                bf16_t* bp = qkvb + (size_t)row * NQKV + u.pn * 256 + cl0;
                float* kvp = nullptr;
                if (c > 0) {
                    if (row < MP) { const int b = row >> 13, t = row & (SEQ - 1); if (t >= SEQ - W) kvp = out + okp + ((size_t)(b * W + t - (SEQ - W)) * 2 + (c - 1)) * 256 + cl0; }
                    else { const int rs = row - MP, b = rs >> 3, t = rs & 7; kvp = out + oks + ((size_t)(b * W + W - 8 + t) * 2 + (c - 1)) * 256 + cl0; }
                }
#pragma unroll
                for (int bj = 0; bj < 2; ++bj) {
                    const f32x4 o0 = acc[ai][bj][m][0] * s, o1 = acc[ai][bj][m][1] * s;
                    u32x4 w; w.x = cvt_pk_bf16(o0[0], o0[1]); w.y = cvt_pk_bf16(o0[2], o0[3]); w.z = cvt_pk_bf16(o1[0], o1[1]); w.w = cvt_pk_bf16(o1[2], o1[3]);
                    *(u32x4*)(bp + bj * 128) = w;
                    if (kvp) { *(f32x4*)(kvp + bj * 128) = o0; *(f32x4*)(kvp + bj * 128 + 4) = o1; } }
            }
    }
};
struct EpiU {
    static constexpr bool PERM = true, AFTER_DRAIN = false;
    const LAS float* rs; mutable int ui; float* ubuf;
    __device__ __forceinline__ void operator()(const f32x4 (&acc)[2][2][4][2], const Unit& u, int wr, int wc, int fr, int fq) const {
        const int row0 = u.pm * 256 + wr * 64 + fr, col0 = u.pn * 256 + wc * 32 + 8 * fq;
        float sc[2][4];
        { const LAS float* t_ = rs + ui * 256 + wr * 64 + fr;
#pragma unroll
          for (int ai = 0; ai < 2; ++ai)
#pragma unroll
              for (int m = 0; m < 4; ++m) sc[ai][m] = t_[ai * 128 + m * 16];
          ++ui; }
#pragma unroll
        for (int ai = 0; ai < 2; ++ai)
#pragma unroll
            for (int m = 0; m < 4; ++m) {
                const int row = row0 + ai * 128 + m * 16; const float s = sc[ai][m];
                float* rp = ubuf + (size_t)row * D + col0;
#pragma unroll
                for (int bj = 0; bj < 2; ++bj) { *(f32x4*)(rp + bj * 128) = acc[ai][bj][m][0] * s; *(f32x4*)(rp + bj * 128 + 4) = acc[ai][bj][m][1] * s; }
            }
    }
};
struct EpiGLU {
    static constexpr bool PERM = true, AFTER_DRAIN = false;
    const bf16_t* gbuf; const float* bglu; bf16_t* zb;
    __device__ __forceinline__ void operator()(const f32x4 (&acc)[2][2][4][2], const Unit& u, int wr, int wc, int fr, int fq) const {
        const int row0 = u.pm * 256 + wr * 64 + fr, col0 = u.pn * 256 + wc * 32 + 8 * fq;
        f32x4 bv[2][2]; u32x4 gw[2], gn[2];
#pragma unroll
        for (int bj = 0; bj < 2; ++bj)
#pragma unroll
            for (int n = 0; n < 2; ++n) bv[bj][n] = *(const f32x4*)(bglu + col0 + bj * 128 + 4 * n);
#pragma unroll
        for (int bj = 0; bj < 2; ++bj) gw[bj] = *(const u32x4*)(gbuf + (size_t)row0 * D + col0 + bj * 128);
#pragma unroll
        for (int i = 0; i < 8; ++i) {
            const int ai = i >> 2, m = i & 3, row = row0 + ai * 128 + m * 16; bf16_t* zp = zb + (size_t)row * D + col0;
            if (i < 7) { const int i2 = i + 1;
#pragma unroll
                for (int bj = 0; bj < 2; ++bj) gn[bj] = *(const u32x4*)(gbuf + (size_t)(row0 + (i2 >> 2) * 128 + (i2 & 3) * 16) * D + col0 + bj * 128); }
#pragma unroll
            for (int bj = 0; bj < 2; ++bj) {
                const u32x4 g8 = gw[bj]; const f32x4 a0 = acc[ai][bj][m][0] + bv[bj][0], a1 = acc[ai][bj][m][1] + bv[bj][1];
                u32x4 w;
                w.x = cvt_pk_bf16(__uint_as_float(g8.x << 16) * fast_sigmoid(a0[0]), __uint_as_float(g8.x & 0xffff0000u) * fast_sigmoid(a0[1]));
                w.y = cvt_pk_bf16(__uint_as_float(g8.y << 16) * fast_sigmoid(a0[2]), __uint_as_float(g8.y & 0xffff0000u) * fast_sigmoid(a0[3]));
                w.z = cvt_pk_bf16(__uint_as_float(g8.z << 16) * fast_sigmoid(a1[0]), __uint_as_float(g8.z & 0xffff0000u) * fast_sigmoid(a1[1]));
                w.w = cvt_pk_bf16(__uint_as_float(g8.w << 16) * fast_sigmoid(a1[2]), __uint_as_float(g8.w & 0xffff0000u) * fast_sigmoid(a1[3]));
                *(u32x4*)(zp + bj * 128) = w; }
            gw[0] = gn[0]; gw[1] = gn[1];
        }
    }
};

template <class Epi> __device__ __forceinline__ void run_gemm(LAS unsigned char* lds, const bf16_t* A, const bf16_t* Bt, int N, int K, const Epi& E, int M = MT) {
    pg8::Gemm g; g.A = A; g.Bt = Bt; g.M = M; g.N = N; g.K = K;
    pg8::StaticOrder S; S.init(M, N, (int)gridDim.x, (int)blockIdx.x);
    pg8::gemm_phase<Epi, pg8::StaticOrder, true, true>(lds, g, S, E);
}

constexpr int RS_OFF = 131072;
__device__ __forceinline__ void rs_prepass(LAS unsigned char* lds, const float* ssq, int M, int N, int tid) {
    pg8::StaticOrder S; S.init(M, N, (int)gridDim.x, (int)blockIdx.x);
    LAS float* tab = (LAS float*)(lds + RS_OFF);
    int tq_ = tid; asm volatile("" : "+v"(tq_));
    const int r = tq_ & 255, h = tq_ >> 8;
    f32x4 p[4][4]; bool ok[4];
#pragma unroll
    for (int k = 0; k < 4; ++k) { Unit u; ok[k] = S.next(h + 2 * k, u);
        if (ok[k]) { const f32x4* q = (const f32x4*)(ssq + (size_t)(u.pm * 256 + r) * 16); p[k][0] = q[0]; p[k][1] = q[1]; p[k][2] = q[2]; p[k][3] = q[3]; } }
#pragma unroll
    for (int k = 0; k < 4; ++k) if (ok[k]) {
        const f32x4 a0 = p[k][0], b0 = p[k][1], c0 = p[k][2], d0 = p[k][3];
        const float t = (((a0[0] + a0[1]) + (a0[2] + a0[3])) + ((b0[0] + b0[1]) + (b0[2] + b0[3]))) + (((c0[0] + c0[1]) + (c0[2] + c0[3])) + ((d0[0] + d0[1]) + (d0[2] + d0[3])));
        tab[(h + 2 * k) * 256 + r] = rsqrtf(t * (1.0f / D) + NORM_EPS); }
    __syncthreads();
}

__device__ __forceinline__ float wave_sum(float v) {
#pragma unroll
    for (int o = 1; o < 64; o <<= 1) v += __shfl_xor(v, o);
    return v;
}
__device__ __forceinline__ float wave_max(float v) {
#pragma unroll
    for (int o = 1; o < 64; o <<= 1) v = fmaxf(v, __shfl_xor(v, o));
    return v;
}
__device__ __forceinline__ void p0_transpose_item(const float* W, int K, int N, bf16_t* WT, int mode, const float* gain, LAS float* scr, int item, int lane) {
    const int nblk = N / 32, kb = item / nblk, nb = item - kb * nblk, k0 = 64 * kb, n0 = 32 * nb;
#pragma unroll 16
    for (int i = 0; i < 32; ++i) { const int kk = 2 * i + (lane >> 5); float v = __builtin_nontemporal_load(W + (size_t)(k0 + kk) * N + n0 + (lane & 31)); if (gain) v *= gain[k0 + kk]; scr[kk * 33 + (lane & 31)] = v; }
    __builtin_amdgcn_s_waitcnt(0xC07F); asm volatile("" ::: "memory");
    const int c = lane & 7;
#pragma unroll
    for (int j = 0; j < 4; ++j) { const int nl = (lane >> 3) + 8 * j, n = n0 + nl; const LAS float* s = scr + (8 * c) * 33 + nl;
        u32x4 o; o.x = cvt_pk_bf16(s[0 * 33], s[1 * 33]); o.y = cvt_pk_bf16(s[2 * 33], s[3 * 33]); o.z = cvt_pk_bf16(s[4 * 33], s[5 * 33]); o.w = cvt_pk_bf16(s[6 * 33], s[7 * 33]);
        const int dr = mode == 0 ? n : (256 * (n >> 7) + (n & 127) + (mode == 2 ? 128 : 0));
        *(u32x4*)(WT + (size_t)dr * K + k0 + 8 * c) = o; }
    __builtin_amdgcn_s_waitcnt(0xC07F); asm volatile("" ::: "memory");
}

struct Args { const float* in[25]; float* out; unsigned char* ws; };

constexpr unsigned KV_PART = 18432u;
__host__ __device__ constexpr unsigned kv_tot(int g) { return 32u * ((128u << (2 * g)) - 8u) * 128u; }
__host__ __device__ constexpr unsigned kv_parts(int g) { return (kv_tot(g) + KV_PART - 1u) / KV_PART; }
__device__ __forceinline__ void kvg_copy(const Args& a, int g, unsigned lo, unsigned hi, unsigned t, unsigned nt) {
    const unsigned W = 128u << (2 * g), per_b = (W - 8u) * 128u;
    const f32x4* src = (const f32x4*)a.in[2 + g] + 8 * 128; f32x4* dst = (f32x4*)(a.out + (g == 0 ? O_KVS0 : (g == 1 ? O_KVS1 : O_KVS2)));
    for (unsigned i = lo + t; i < hi; i += 4u * nt) {
        f32x4 v[4]; unsigned off[4];
#pragma unroll
        for (int k = 0; k < 4; ++k) { const unsigned ii = i + (unsigned)k * nt; off[k] = 0xffffffffu;
            if (ii < hi) { const unsigned b = ii / per_b, r = ii - b * per_b; off[k] = b * W * 128u + r; v[k] = src[off[k]]; } }
#pragma unroll
        for (int k = 0; k < 4; ++k) if (off[k] != 0xffffffffu) __builtin_nontemporal_store(v[k], dst + off[k]);
    }
}
__device__ __forceinline__ void kv_slice(const Args& a, unsigned p, unsigned t) {
    int g; unsigned q;
    if (p < kv_parts(2)) { g = 2; q = p; } else if (p < kv_parts(2) + kv_parts(1)) { g = 1; q = p - kv_parts(2); } else if (p < kv_parts(2) + kv_parts(1) + kv_parts(0)) { g = 0; q = p - kv_parts(2) - kv_parts(1); } else return;
    const unsigned tot = 32u * ((128u << (2 * g)) - 8u) * 128u, lo = q * KV_PART, hi = lo + KV_PART < tot ? lo + KV_PART : tot;
    kvg_copy(a, g, lo, hi, t, NTHREADS);
}
__device__ __forceinline__ void p0_prologue(const Args& a, LAS unsigned char* lds, int wave, int lane) {
    unsigned char* ws = a.ws;
    LAS float* scr = (LAS float*)(lds + wave * 16384);
    const int gw = blockIdx.x * NWAVES + wave, NGW = gridDim.x * NWAVES;
    const float* norm_g = a.in[6];
    constexpr int I_GU = (D / 64) * (FF / 32), I_DN = (FF / 64) * (D / 32), I_QKV = (D / 64) * (NQKV / 32), I_O = (AW / 64) * (D / 32), I_SQ = (D / 64) * (D / 32);
    constexpr int NITEMS = 8 * I_GU + 4 * I_DN + I_QKV + I_O + 3 * I_SQ;
    for (int it = gw; it < NITEMS; it += NGW) {
        int r = it;
        if (r < 8 * I_GU) { const int w = r / I_GU, lf = w >> 1, isup = w & 1; r -= w * I_GU;
            const int layer = lf >> 1, f = lf & 1;
            p0_transpose_item((isup ? a.in[9] : a.in[8]) + (size_t)lf * D * FF, D, FF, (bf16_t*)(ws + WS_WGU + lf * SZ_WGU), isup ? 2 : 1, norm_g + (layer * 3 + (f ? 2 : 0)) * D, scr, r, lane); continue; }
        r -= 8 * I_GU;
        if (r < 4 * I_DN) { const int lf = r / I_DN; r -= lf * I_DN;
            p0_transpose_item(a.in[10] + (size_t)lf * FF * D, FF, D, (bf16_t*)(ws + WS_WD + lf * SZ_WD), 0, nullptr, scr, r, lane); continue; }
        r -= 4 * I_DN;
        if (r < I_QKV) { p0_transpose_item(a.in[11], D, NQKV, (bf16_t*)(ws + WS_WQKV), 0, norm_g + 1 * D, scr, r, lane); continue; }
        r -= I_QKV;
        if (r < I_O) { p0_transpose_item(a.in[12], AW, D, (bf16_t*)(ws + WS_WO), 0, nullptr, scr, r, lane); continue; }
        r -= I_O;
        if (r < I_SQ) { p0_transpose_item(a.in[13], D, D, (bf16_t*)(ws + WS_WIN), 0, norm_g + 4 * D, scr, r, lane); continue; }
        r -= I_SQ;
        if (r < I_SQ) { p0_transpose_item(a.in[22], D, D, (bf16_t*)(ws + WS_WGLU), 0, nullptr, scr, r, lane); continue; }
        r -= I_SQ;
        p0_transpose_item(a.in[24], D, D, (bf16_t*)(ws + WS_WOUT), 0, nullptr, scr, r, lane);
    }
    {
        bf16_t* xb = (bf16_t*)(ws + WS_XB); float* ssq0 = (float*)(ws + WS_SSQ);
        for (int row = gw; row < MT; row += NGW) {
            const float* src = row < MP ? a.in[0] + (size_t)row * D : a.in[1] + (size_t)(row - MP) * D;
            float s = 0.f;
#pragma unroll
            for (int j = 0; j < 4; ++j) {
                const f32x4 v = __builtin_nontemporal_load((const f32x4*)(src + 256 * j + 4 * lane));
                u32x2 w; w.x = cvt_pk_bf16(v[0], v[1]); w.y = cvt_pk_bf16(v[2], v[3]);
                *(u32x2*)(xb + (size_t)row * D + 256 * j + 4 * lane) = w;
                s += (v[0] * v[0] + v[1] * v[1]) + (v[2] * v[2] + v[3] * v[3]); }
            s = wave_sum(s);
            if (lane < 16) ssq0[(size_t)row * 16 + lane] = lane == 0 ? s : 0.f;
        }
    }
    {
        const size_t gt = (size_t)blockIdx.x * NTHREADS + threadIdx.x, NT = (size_t)gridDim.x * NTHREADS;
        const int G_ = (int)gridDim.x; const unsigned kv_nslots = (unsigned)(4 * (G_ - (65 * 22) % G_) + (G_ - (65 * 9) % G_));
#pragma unroll 1
        for (int g = 0; g < 3; ++g) {
            const int W = 128 << (2 * g); const unsigned per_b = (unsigned)(W - 8) * 128u, tot = 32u * per_b;
            const f32x4* src = (const f32x4*)a.in[2 + g]; f32x4* dst = (f32x4*)(a.out + (g == 0 ? O_KVS0 : (g == 1 ? O_KVS1 : O_KVS2)));
            const unsigned before = g == 2 ? 0u : (g == 1 ? kv_parts(2) : kv_parts(2) + kv_parts(1)), npg = g == 2 ? kv_parts(2) : (g == 1 ? kv_parts(1) : kv_parts(0));
            const unsigned cov = kv_nslots > before ? (kv_nslots - before < npg ? kv_nslots - before : npg) : 0u;
            const unsigned kv_start = cov * KV_PART < tot ? cov * KV_PART : tot;
            for (unsigned i = kv_start + (unsigned)gt; i < tot; i += 4u * (unsigned)NT) {
                f32x4 v[4]; unsigned off[4];
#pragma unroll
                for (int k = 0; k < 4; ++k) { const unsigned ii = i + (unsigned)k * (unsigned)NT; off[k] = 0xffffffffu;
                    if (ii < tot) { const unsigned b = ii / per_b, r = ii - b * per_b; off[k] = b * (unsigned)W * 128u + r; v[k] = __builtin_nontemporal_load(src + off[k] + 8 * 128); } }
#pragma unroll
                for (int k = 0; k < 4; ++k) if (off[k] != 0xffffffffu) __builtin_nontemporal_store(v[k], dst + off[k]);
            }
        }
        if (gt < 64 * 64) {
            const int g = (int)gt >> 6;
            const float are = a.in[14][gt], aim = a.in[15][gt], dt = expf(a.in[16][g]);
            const float mag = expf(are * dt), ang = aim * dt;
            float sn, cs; sincosf(ang, &sn, &cs);
            const float lre = mag * cs, lim = mag * sn, den = are * are + aim * aim, nre = lre - 1.0f;
            const float cre = (nre * are + lim * aim) / den, cim = (lim * are - nre * aim) / den;
            float pre = lre, pim = lim;
#pragma unroll
            for (int i = 0; i < 7; ++i) { const float t = pre * pre - pim * pim; pim = 2.f * pre * pim; pre = t; }
            float* lam = (float*)(ws + WS_LAM) + gt * 4; lam[0] = lre; lam[1] = lim; lam[2] = pre; lam[3] = pim;
            float* bb = (float*)(ws + WS_BB) + gt * 32; const float* bre = a.in[17] + gt * 16; const float* bim = a.in[18] + gt * 16;
#pragma unroll
            for (int c = 0; c < 16; ++c) { bb[c] = cre * bre[c] - cim * bim[c]; bb[16 + c] = cre * bim[c] + cim * bre[c]; }
        }
    }
}

constexpr int KL_PITCH = 72, VT_PITCH = 328, PW_PITCH = 168;
constexpr int ATT_KL = 0, ATT_VT = 256 * KL_PITCH * 2, ATT_PW = ATT_VT + 64 * VT_PITCH * 2, ATT_PW_WAVE = 16 * PW_PITCH * 2;
__device__ __forceinline__ void attn_prompt_item(LAS unsigned char* lds, const bf16_t* qkvb, bf16_t* og, float* lse, int it, int tid, int wave, int lane) {
    const int b = it / 768, rem0 = it - b * 768, g = rem0 >> 8, rem = rem0 & 255, hh = rem & 3, rq = rem >> 2;
    const int dl = 2 * g, dil = 1 << dl, r = rq & (dil - 1), qb = rq >> dl;
    const float slope = exp2f(-8.0f * (float)(g * 4 + hh + 1) / 12.0f);
    LAS bf16_t* Kl = (LAS bf16_t*)(lds + ATT_KL); LAS bf16_t* Vt = (LAS bf16_t*)(lds + ATT_VT); LAS bf16_t* Pw = (LAS bf16_t*)(lds + ATT_PW + wave * ATT_PW_WAVE);
    const int colk = AW + g * 256 + hh * 64;
#pragma unroll
    for (int pp = 0; pp < 4; ++pp) {
        const int p = tid + pp * NTHREADS, j = p >> 3, pc = p & 7, si = qb * 128 - 128 + j;
        u32x4 kv = (u32x4){0u, 0u, 0u, 0u}, vv = (u32x4){0u, 0u, 0u, 0u};
        if (si >= 0) { const bf16_t* kp = qkvb + (size_t)(b * SEQ + si * dil + r) * NQKV + colk + pc * 8; kv = *(const u32x4*)kp; vv = *(const u32x4*)(kp + AW); }
        *(LAS u32x4*)(Kl + j * KL_PITCH + pc * 8) = kv;
        LAS bf16_t* vd = Vt + (pc * 8) * VT_PITCH + ((((j >> 3) ^ pc) << 3) | (j & 7));
        vd[0 * VT_PITCH] = (bf16_t)(vv.x & 0xffffu); vd[1 * VT_PITCH] = (bf16_t)(vv.x >> 16); vd[2 * VT_PITCH] = (bf16_t)(vv.y & 0xffffu); vd[3 * VT_PITCH] = (bf16_t)(vv.y >> 16);
        vd[4 * VT_PITCH] = (bf16_t)(vv.z & 0xffffu); vd[5 * VT_PITCH] = (bf16_t)(vv.z >> 16); vd[6 * VT_PITCH] = (bf16_t)(vv.w & 0xffffu); vd[7 * VT_PITCH] = (bf16_t)(vv.w >> 16);
    }
    { const int d = tid >> 3, blk = 32 + (tid & 7); *(LAS u32x4*)(Vt + d * VT_PITCH + blk * 8) = (u32x4){0u, 0u, 0u, 0u}; }
    const int ql = lane & 15, fq = lane >> 4;
    const size_t qrow = (size_t)b * SEQ + (size_t)(qb * 128 + 16 * wave + ql) * dil + r;
    const bf16_t* qp = qkvb + qrow * NQKV + g * 256 + hh * 64;
    const bf16x8 q0 = *(const bf16x8*)(qp + 8 * fq), q1 = *(const bf16x8*)(qp + 32 + 8 * fq);
    __syncthreads();
    f32x4 sc[9]; float mx = -1e30f;
#pragma unroll
    for (int T = 0; T < 9; ++T) {
        const LAS bf16_t* kr = Kl + (16 * (wave + T) + ql) * KL_PITCH + 8 * fq;
        const bf16x8 a0 = *(const LAS bf16x8*)kr, a1 = *(const LAS bf16x8*)(kr + 32);
        f32x4 acc = (f32x4){0.f, 0.f, 0.f, 0.f};
        acc = __builtin_amdgcn_mfma_f32_16x16x32_bf16(a0, q0, acc, 0, 0, 0);
        acc = __builtin_amdgcn_mfma_f32_16x16x32_bf16(a1, q1, acc, 0, 0, 0);
#pragma unroll
        for (int j = 0; j < 4; ++j) {
            const int krel = 16 * T + 4 * fq + j, delta = 128 + ql - krel, ksub = qb * 128 - 128 + 16 * wave + krel;
            const bool valid = (delta >= 0) && (delta <= 128) && (ksub >= 0);
            const float s = valid ? acc[j] * 0.125f - slope * (float)(delta * dil) : -1e30f;
            acc[j] = s; mx = fmaxf(mx, s); }
        sc[T] = acc;
    }
    mx = fmaxf(mx, __shfl_xor(mx, 16)); mx = fmaxf(mx, __shfl_xor(mx, 32));
    float den = 0.f;
#pragma unroll
    for (int T = 0; T < 9; ++T) {
        f32x4 p;
#pragma unroll
        for (int j = 0; j < 4; ++j) { p[j] = sc[T][j] > -1e29f ? __expf(sc[T][j] - mx) : 0.f; den += p[j]; }
        u32x2 w; w.x = cvt_pk_bf16(p[0], p[1]); w.y = cvt_pk_bf16(p[2], p[3]);
        *(LAS u32x2*)(Pw + ql * PW_PITCH + 16 * T + 4 * fq) = w;
    }
    *(LAS u32x2*)(Pw + ql * PW_PITCH + 144 + 4 * fq) = (u32x2){0u, 0u};
    den += __shfl_xor(den, 16); den += __shfl_xor(den, 32);
    const float inv = 1.0f / den;
    __syncthreads();
    bf16_t* op = og + qrow * AW + g * 256 + hh * 64 + 4 * fq;
#pragma unroll
    for (int dt = 0; dt < 4; ++dt) {
        f32x4 o = (f32x4){0.f, 0.f, 0.f, 0.f};
#pragma unroll
        for (int ks = 0; ks < 5; ++ks) {
            const bf16x8 av = *(const LAS bf16x8*)(Vt + (16 * dt + ql) * VT_PITCH + (((2 * wave + 4 * ks + fq) ^ ((2 * dt + (ql >> 3)) & 7)) << 3));
            const bf16x8 bp = *(const LAS bf16x8*)(Pw + ql * PW_PITCH + 32 * ks + 8 * fq);
            o = __builtin_amdgcn_mfma_f32_16x16x32_bf16(av, bp, o, 0, 0, 0); }
        u32x2 w; w.x = cvt_pk_bf16(o[0] * inv, o[1] * inv); w.y = cvt_pk_bf16(o[2] * inv, o[3] * inv);
        *(u32x2*)(op + 16 * dt) = w;
    }
    if (fq == 0) lse[qrow * 12 + g * 4 + hh] = mx + __logf(den);
    __syncthreads();
}

__device__ __forceinline__ void attn_sample_item(const Args& a, const bf16_t* qkvb, bf16_t* og, float* lse, int it, int lane) {
    const int t = it & 7, hh = (it >> 3) & 3, bg = it >> 5, b = bg / 3, g = bg - 3 * b;
    const int W = 128 << (2 * g), dil = 1 << (2 * g);
    const float slope = exp2f(-8.0f * (float)(g * 4 + hh + 1) / 12.0f);
    const int row = MP + b * 8 + t;
    const float* cache = a.in[2 + g] + (size_t)b * W * 512 + hh * 64;
    const float* kvs = a.out + (g == 0 ? O_KVS0 : (g == 1 ? O_KVS1 : O_KVS2)) + (size_t)b * W * 512 + hh * 64;
    const bf16_t* qp = qkvb + (size_t)row * NQKV + g * 256 + hh * 64;
    float q[64];
#pragma unroll
    for (int i = 0; i < 8; ++i) { const u32x4 w = *(const u32x4*)(qp + 8 * i);
        q[8 * i + 0] = __uint_as_float(w.x << 16); q[8 * i + 1] = __uint_as_float(w.x & 0xffff0000u); q[8 * i + 2] = __uint_as_float(w.y << 16); q[8 * i + 3] = __uint_as_float(w.y & 0xffff0000u);
        q[8 * i + 4] = __uint_as_float(w.z << 16); q[8 * i + 5] = __uint_as_float(w.z & 0xffff0000u); q[8 * i + 6] = __uint_as_float(w.w << 16); q[8 * i + 7] = __uint_as_float(w.w & 0xffff0000u); }
    float sc[3];
#pragma unroll
    for (int pass = 0; pass < 3; ++pass) {
        const int j = lane + 64 * pass; const bool valid = j <= 128; const int jj = valid ? j : 128;
        const int idx = W + t - jj * dil;
        const float* kp = idx < W ? cache + (size_t)idx * 512 : kvs + (size_t)(idx - 8) * 512;
        float dot = 0.f;
#pragma unroll
        for (int i = 0; i < 16; ++i) { const f32x4 k4 = *(const f32x4*)(kp + 4 * i); dot += (q[4 * i] * k4[0] + q[4 * i + 1] * k4[1]) + (q[4 * i + 2] * k4[2] + q[4 * i + 3] * k4[3]); }
        sc[pass] = valid ? dot * 0.125f - slope * (float)(jj * dil) : -1e30f;
    }
    const float mx = wave_max(fmaxf(fmaxf(sc[0], sc[1]), sc[2]));
    float p[3];
#pragma unroll
    for (int pass = 0; pass < 3; ++pass) p[pass] = sc[pass] > -1e29f ? __expf(sc[pass] - mx) : 0.f;
    const float den = wave_sum(p[0] + p[1] + p[2]);
    float o = 0.f;
#pragma unroll 1
    for (int j0 = 0; j0 < 128; j0 += 32) {
        float v[32];
#pragma unroll
        for (int u = 0; u < 32; ++u) { const int idx = W + t - (j0 + u) * dil;
            const float* vp = (idx < W ? cache + (size_t)idx * 512 : kvs + (size_t)(idx - 8) * 512) + 256; v[u] = vp[lane]; }
        const float psrc = j0 < 64 ? p[0] : p[1];
#pragma unroll
        for (int u = 0; u < 32; ++u) o += __shfl(psrc, (j0 & 63) + u) * v[u];
    }
    o += __shfl(p[2], 0) * (cache + (size_t)t * 512 + 256)[lane];
    og[(size_t)row * AW + g * 256 + hh * 64 + lane] = (bf16_t)(cvt_pk_bf16(o / den, 0.f) & 0xffffu);
    if (lane == 0) lse[(size_t)row * 12 + g * 4 + hh] = mx + __logf(den);
}

__device__ __forceinline__ void merge_phase(const bf16_t* og, const float* lse, bf16_t* om) {
    const size_t gt = (size_t)blockIdx.x * NTHREADS + threadIdx.x, NT = (size_t)gridDim.x * NTHREADS, tot = (size_t)MT * 96;
    for (size_t i = gt; i < tot; i += NT) {
        const size_t row = i / 96; const int c8 = (int)(i - row * 96), col = c8 * 8, g = col >> 8, hh = (col & 255) >> 6;
        const float l0 = lse[row * 12 + hh], l1 = lse[row * 12 + 4 + hh], l2 = lse[row * 12 + 8 + hh];
        const float m = fmaxf(fmaxf(l0, l1), l2), e0 = __expf(l0 - m), e1 = __expf(l1 - m), e2 = __expf(l2 - m);
        const float al = (g == 0 ? e0 : (g == 1 ? e1 : e2)) / (e0 + e1 + e2);
        const u32x4 w = *(const u32x4*)(og + row * AW + col); u32x4 o;
        o.x = cvt_pk_bf16(__uint_as_float(w.x << 16) * al, __uint_as_float(w.x & 0xffff0000u) * al);
        o.y = cvt_pk_bf16(__uint_as_float(w.y << 16) * al, __uint_as_float(w.y & 0xffff0000u) * al);
        o.z = cvt_pk_bf16(__uint_as_float(w.z << 16) * al, __uint_as_float(w.z & 0xffff0000u) * al);
        o.w = cvt_pk_bf16(__uint_as_float(w.w << 16) * al, __uint_as_float(w.w & 0xffff0000u) * al);
        *(u32x4*)(om + row * AW + col) = o;
    }
}

constexpr int XB_PITCH = 136, BU_PITCH = 130, SC_CP = 68, SC_CRE = 0, SC_CIM = 16 * SC_CP * 4, SC_WAVE0 = 0, SC_UL = 0, SC_XRE = 4096, SC_BU = 4096 + 16 * XB_PITCH * 2, SC_WAVE = SC_BU + 16 * BU_PITCH * 4;
__device__ __forceinline__ float gelu_tanh(float x) {
    const float z = 0.7978845608028654f * (x + 0.044715f * x * x * x);
    const float th = 1.0f - 2.0f * __builtin_amdgcn_rcpf(__expf(2.0f * z) + 1.0f);
    return 0.5f * x * (1.0f + th);
}
typedef float f32x2v __attribute__((ext_vector_type(2)));
template <bool PROJECT>
__device__ __forceinline__ void scan_run(LAS unsigned char* lds, int wave, int lane, const float* ubuf, int row0, int ntok, int g, const float* lamp, const float* bbp, const float* dsk, const float* c_re, const float* c_im, bf16_t* gbuf, float& hre, float& him,
                                         bool reload, bf16x8 (&bop)[2][4], bf16x8 (&cop)[4], float& lre, float& lim, float& dv) {
    LAS unsigned char* wb = lds + SC_WAVE0 + wave * SC_WAVE;
    LAS float* Uh = (LAS float*)(wb + SC_UL); LAS bf16_t* Xb = (LAS bf16_t*)(wb + SC_XRE);
    LAS float* BUl = (LAS float*)(wb + SC_BU);
    const int c0 = 8 * ((lane >> 4) & 1), part = lane >> 5;
    const int c = lane & 15, tq = lane >> 4;
    if (reload) {
      lre = lamp[0]; lim = lamp[1];
      const float* bbg = bbp - (size_t)lane * 32;
#pragma unroll
      for (int i = 0; i < 4; ++i) { const float* bp = bbg + (size_t)(16 * i + (lane & 15)) * 32 + c0;
#pragma unroll
          for (int pr = 0; pr < 2; ++pr) { const f32x4 a0 = *(const f32x4*)(bp + 16 * pr), a1 = *(const f32x4*)(bp + 16 * pr + 4);
              u32x4 w; w.x = cvt_pk_bf16(a0[0], a0[1]); w.y = cvt_pk_bf16(a0[2], a0[3]); w.z = cvt_pk_bf16(a1[0], a1[1]); w.w = cvt_pk_bf16(a1[2], a1[3]);
              bop[pr][i] = __builtin_bit_cast(bf16x8, w); } }
      dv = PROJECT ? dsk[g * 16 + c] : 0.f;
    }
    if (PROJECT && reload) {
#pragma unroll
        for (int ks = 0; ks < 4; ++ks) { const size_t co = (size_t)(g * 16 + c) * 64 + 16 * ks + 4 * tq;
            const f32x4 a0 = *(const f32x4*)(c_re + co), a1 = *(const f32x4*)(c_im + co);
            u32x4 w; w.x = cvt_pk_bf16(a0[0], -a1[0]); w.y = cvt_pk_bf16(a0[1], -a1[1]); w.z = cvt_pk_bf16(a0[2], -a1[2]); w.w = cvt_pk_bf16(a0[3], -a1[3]);
            cop[ks] = __builtin_bit_cast(bf16x8, w); }
    }
    const int utt = lane >> 2, ucc = (lane & 3) * 4;
    f32x4 uh[4];
#pragma unroll
    for (int i = 0; i < 4; ++i) { uh[i] = (f32x4){0.f, 0.f, 0.f, 0.f}; if (16 * i + utt < ntok) uh[i] = *(const f32x4*)(ubuf + (size_t)(row0 + 16 * i + utt) * D + g * 16 + ucc); }
    const int nhalf = ntok > 64 ? 2 : 1;
#pragma unroll 1
    for (int half = 0; half < nhalf; ++half) {
#pragma unroll
    for (int i = 0; i < 4; ++i) *(LAS f32x4*)(Uh + (16 * i + utt) * 16 + ucc) = uh[i];
    if (half + 1 < nhalf) {
#pragma unroll
        for (int i = 0; i < 4; ++i) uh[i] = *(const f32x4*)(ubuf + (size_t)(row0 + 64 + 16 * i + utt) * D + g * 16 + ucc); }
    asm volatile("s_waitcnt lgkmcnt(0)" ::: "memory"); __builtin_amdgcn_wave_barrier();
#pragma unroll 1
    for (int tl = 0; tl < 4; ++tl) {
        const int t0 = 64 * half + 16 * tl; if (t0 >= ntok) break;
        const int nsub = (ntok - t0) < 16 ? (ntok - t0) : 16;
        LAS float* Ul = Uh + tl * 256;
        {
            const f32x4 a0 = *(const LAS f32x4*)(Ul + c * 16 + c0), a1 = *(const LAS f32x4*)(Ul + c * 16 + c0 + 4);
            u32x4 wh; wh.x = cvt_pk_bf16(a0[0], a0[1]); wh.y = cvt_pk_bf16(a0[2], a0[3]); wh.z = cvt_pk_bf16(a1[0], a1[1]); wh.w = cvt_pk_bf16(a1[2], a1[3]);
            u32x4 wl;
            wl.x = cvt_pk_bf16(a0[0] - __uint_as_float(wh.x << 16), a0[1] - __uint_as_float(wh.x & 0xffff0000u)); wl.y = cvt_pk_bf16(a0[2] - __uint_as_float(wh.y << 16), a0[3] - __uint_as_float(wh.y & 0xffff0000u));
            wl.z = cvt_pk_bf16(a1[0] - __uint_as_float(wh.z << 16), a1[1] - __uint_as_float(wh.z & 0xffff0000u)); wl.w = cvt_pk_bf16(a1[2] - __uint_as_float(wh.w << 16), a1[3] - __uint_as_float(wh.w & 0xffff0000u));
            u32x4 wsel; wsel.x = part ? wl.x : wh.x; wsel.y = part ? wl.y : wh.y; wsel.z = part ? wl.z : wh.z; wsel.w = part ? wl.w : wh.w;
            const bf16x8 aop = __builtin_bit_cast(bf16x8, wsel);
            f32x4 br[4], bi[4];
#pragma unroll
            for (int i = 0; i < 4; ++i) {
                f32x4 zr = (f32x4){0.f, 0.f, 0.f, 0.f}, zi = zr;
                br[i] = __builtin_amdgcn_mfma_f32_16x16x32_bf16(aop, bop[0][i], zr, 0, 0, 0); bi[i] = __builtin_amdgcn_mfma_f32_16x16x32_bf16(aop, bop[1][i], zi, 0, 0, 0);
            }
            asm volatile("s_nop 15\n\ts_nop 15\n\ts_nop 15\n\ts_nop 15" : "+v"(br[0]), "+v"(br[1]), "+v"(br[2]), "+v"(br[3]), "+v"(bi[0]), "+v"(bi[1]), "+v"(bi[2]), "+v"(bi[3]), "+v"(wsel));
#pragma unroll
            for (int i = 0; i < 4; ++i)
#pragma unroll
                for (int j = 0; j < 4; ++j) *(LAS f32x2v*)(BUl + (4 * tq + j) * BU_PITCH + 2 * (16 * i + c)) = (f32x2v){br[i][j], bi[i][j]};
            asm volatile("s_waitcnt lgkmcnt(0)" ::: "memory"); __builtin_amdgcn_wave_barrier();
        }
        {
            float bur[16], bui[16];
#pragma unroll
            for (int t = 0; t < 16; ++t) { const f32x2v bu = *(const LAS f32x2v*)(BUl + t * BU_PITCH + 2 * lane); bur[t] = bu.x; bui[t] = bu.y; }
#pragma unroll
            for (int t = 0; t < 16; ++t) {
                const float nre = lre * hre - lim * him + bur[t], nim = lre * him + lim * hre + bui[t];
                if (t < nsub) { hre = nre; him = nim; }
                if (PROJECT) *(LAS unsigned*)(Xb + t * XB_PITCH + 2 * lane) = cvt_pk_bf16(hre, him);
            }
        }
        if (PROJECT) {
            asm volatile("s_waitcnt lgkmcnt(0)" ::: "memory"); __builtin_amdgcn_wave_barrier();
            f32x4 y = (f32x4){0.f, 0.f, 0.f, 0.f};
#pragma unroll
            for (int ks = 0; ks < 4; ++ks) { const bf16x8 ax = *(const LAS bf16x8*)(Xb + c * XB_PITCH + 32 * ks + 8 * tq); y = __builtin_amdgcn_mfma_f32_16x16x32_bf16(ax, cop[ks], y, 0, 0, 0); }
#pragma unroll
            for (int i = 0; i < 4; ++i) { const int t = 4 * tq + i;
                if (t < nsub) { const float v = y[i] + dv * Ul[t * 16 + c];
                    gbuf[(size_t)(row0 + t0 + t) * D + g * 16 + c] = (bf16_t)(cvt_pk_bf16(gelu_tanh(v), 0.f) & 0xffffu); } }
            asm volatile("s_waitcnt lgkmcnt(0)" ::: "memory"); __builtin_amdgcn_wave_barrier();
        }
    }
    }
}
__device__ __forceinline__ void load_c(LAS unsigned char* lds, const float* cre, const float* cim, int g, int tid) {
    LAS float* Cre = (LAS float*)(lds + SC_CRE); LAS float* Cim = (LAS float*)(lds + SC_CIM);
    for (int e = tid; e < 1024; e += NTHREADS) { const int c = e >> 6, n = e & 63; Cre[c * SC_CP + n] = cre[g * 1024 + e]; Cim[c * SC_CP + n] = cim[g * 1024 + e]; }
}

struct SEpiRes {
    static constexpr bool HAS_SSQ = true;
    bf16_t* xb; float* ssq_out; float scale;
    __device__ __forceinline__ float apply(const f32x4 acc, int row, int col, int fq) const {
        bf16_t* bp = xb + (size_t)row * D + col; const u32x2 r = *(const u32x2*)bp; f32x4 o;
        o[0] = __uint_as_float(r.x << 16); o[1] = __uint_as_float(r.x & 0xffff0000u); o[2] = __uint_as_float(r.y << 16); o[3] = __uint_as_float(r.y & 0xffff0000u);
        o += acc * scale;
        u32x2 w; w.x = cvt_pk_bf16(o[0], o[1]); w.y = cvt_pk_bf16(o[2], o[3]); *(u32x2*)bp = w;
        return (o[0] * o[0] + o[1] * o[1]) + (o[2] * o[2] + o[3] * o[3]);
    }
};
struct SEpiU {
    static constexpr bool HAS_SSQ = false;
    const float* ssq; float* ubuf; float* ssq_out;
    __device__ __forceinline__ float apply(const f32x4 acc, int row, int col, int fq) const {
        const f32x4 p = *(const f32x4*)(ssq + (size_t)row * 16 + 4 * fq); float t = (p[0] + p[1]) + (p[2] + p[3]); t += __shfl_xor(t, 16); t += __shfl_xor(t, 32);
        const float sc = rsqrtf(t * (1.0f / D) + NORM_EPS);
        *(f32x4*)(ubuf + (size_t)row * D + col) = acc * sc; return 0.f;
    }
};
struct SEpiGLU {
    static constexpr bool HAS_SSQ = false;
    const bf16_t* gbuf; const float* bglu; bf16_t* zb; float* ssq_out;
    __device__ __forceinline__ float apply(const f32x4 acc, int row, int col, int fq) const {
        const u32x2 g4 = *(const u32x2*)(gbuf + (size_t)row * D + col); const f32x4 av = acc + *(const f32x4*)(bglu + col);
        u32x2 w; w.x = cvt_pk_bf16(__uint_as_float(g4.x << 16) * fast_sigmoid(av[0]), __uint_as_float(g4.x & 0xffff0000u) * fast_sigmoid(av[1]));
        w.y = cvt_pk_bf16(__uint_as_float(g4.y << 16) * fast_sigmoid(av[2]), __uint_as_float(g4.y & 0xffff0000u) * fast_sigmoid(av[3]));
        *(u32x2*)(zb + (size_t)row * D + col) = w; return 0.f;
    }
};
template <class SEpi>
__device__ __forceinline__ void sample_gemm(LAS unsigned char* lds, const bf16_t* A, const bf16_t* Bt, int K, const SEpi& E, int wave, int lane) {
    LAS f32x4* red = (LAS f32x4*)lds; LAS float* P = (LAS float*)(lds + 32768);
    const int fr = lane & 15, fq = lane >> 4, nks = K >> 8;
#pragma unroll 1
    for (int piece = blockIdx.x; piece < 256; piece += gridDim.x) {
        const int rt = piece >> 4, cg = piece & 15, row = MP + 16 * rt + fr;
        const bf16_t* ap = A + (size_t)row * K + wave * (K >> 3) + 8 * fq; const bf16_t* bp = Bt + (size_t)(64 * cg + fr) * K + wave * (K >> 3) + 8 * fq;
        f32x4 acc[4];
#pragma unroll
        for (int c = 0; c < 4; ++c) acc[c] = (f32x4){0.f, 0.f, 0.f, 0.f};
#pragma unroll 1
        for (int k0 = 0; k0 < nks; k0 += 4) {
            bf16x8 af[4], bf[4][4];
#pragma unroll
            for (int u = 0; u < 4; ++u) { const int ks = (k0 + u < nks) ? k0 + u : k0;
                af[u] = *(const bf16x8*)(ap + 32 * ks);
#pragma unroll
                for (int c = 0; c < 4; ++c) bf[u][c] = *(const bf16x8*)(bp + (size_t)(16 * c) * K + 32 * ks); }
#pragma unroll
            for (int u = 0; u < 4; ++u) if (k0 + u < nks) {
#pragma unroll
                for (int c = 0; c < 4; ++c) acc[c] = __builtin_amdgcn_mfma_f32_16x16x32_bf16(bf[u][c], af[u], acc[c], 0, 0, 0); }
        }
        asm volatile("s_nop 15\n\ts_nop 15" : "+v"(acc[0]), "+v"(acc[1]), "+v"(acc[2]), "+v"(acc[3]));
#pragma unroll
        for (int c = 0; c < 4; ++c) red[(wave * 4 + c) * 64 + lane] = acc[c];
        __syncthreads();
        if (wave < 4) {
            f32x4 t = red[wave * 64 + lane];
#pragma unroll
            for (int w = 1; w < 8; ++w) t += red[(w * 4 + wave) * 64 + lane];
            float q = E.apply(t, row, 64 * cg + 16 * wave + 4 * fq, fq);
            if (SEpi::HAS_SSQ) { q += __shfl_xor(q, 16); q += __shfl_xor(q, 32); if (fq == 0) P[wave * 16 + fr] = q; }
        }
        __syncthreads();
        if (SEpi::HAS_SSQ && wave == 0 && lane < 16) E.ssq_out[(size_t)(MP + 16 * rt + lane) * 16 + cg] = (P[lane] + P[16 + lane]) + (P[32 + lane] + P[48 + lane]);
        __syncthreads();
    }
}

#define XB_TMO      128
#define XB_XCNT(j)  (256  + 64 * (j))
#define XB_XSUB(j)  (1280 + 64 * (j))
#define XB_XGEN(j)  (2304 + 64 * (j))
#define XB_TOP      3328
#define XB_TOPGEN   3392
#define XCD_BAR_WORDS 3456
#define XB_SPIN_CAP (1u << 18)

__device__ __forceinline__ unsigned xb_ld(unsigned* p)              { return __hip_atomic_load(p, __ATOMIC_RELAXED, __HIP_MEMORY_SCOPE_AGENT); }
__device__ __forceinline__ unsigned xb_add(unsigned* p, unsigned v) { return __hip_atomic_fetch_add(p, v, __ATOMIC_RELAXED, __HIP_MEMORY_SCOPE_AGENT); }
__device__ __forceinline__ unsigned xb_xcc_id() { return (unsigned)__builtin_amdgcn_s_getreg((3 << 11) | 20) & 0xFu; }
#define XB_SPIN(cond, bar) do { unsigned _sp = 0; while (cond) { __builtin_amdgcn_s_sleep(1); \
    if ((++_sp & 255u) == 0u) { if (xb_ld(&(bar)[XB_TMO])) break; if (_sp > XB_SPIN_CAP) { atomicAdd(&(bar)[XB_TMO], 1u); break; } } } } while (0)

struct XcdBarrier {
    unsigned* bar; unsigned x;
    volatile LAS unsigned* st;
};

__device__ __forceinline__ XcdBarrier xcd_barrier_post(unsigned* bar, volatile LAS unsigned* st) {
    XcdBarrier b; b.bar = bar; b.x = xb_xcc_id(); b.st = st;
    if (threadIdx.x == 0) (void)xb_add(&bar[XB_XCNT(b.x)], 1u);
    return b;
}
__device__ __forceinline__ void xcd_barrier_complete(unsigned* bar, unsigned x, unsigned& nloc, unsigned& nx) {
    const unsigned G = gridDim.x * gridDim.y * gridDim.z;
    unsigned sum, cnt, mine, sp = 0u;
    for (;;) {
        sum = 0u; cnt = 0u; mine = 0u;
#pragma unroll
        for (unsigned j = 0; j < 16; ++j) { const unsigned c = xb_ld(&bar[XB_XCNT(j)]); sum += c; cnt += (c > 0u) ? 1u : 0u; mine = (j == x) ? c : mine; }
        if (sum == G) break;
        __builtin_amdgcn_s_sleep(1);
        if ((++sp & 255u) == 0u) { if (xb_ld(&bar[XB_TMO])) break; if (sp > XB_SPIN_CAP) { atomicAdd(&bar[XB_TMO], 1u); break; } }
    }
    nloc = mine > 0u ? mine : 1u; nx = cnt > 0u ? cnt : 1u;
}

__device__ __forceinline__ void xcd_barrier(const XcdBarrier& b) {
    asm volatile("s_waitcnt vmcnt(0)" ::: "memory");
    __syncthreads();
    if (threadIdx.x == 0) {
        unsigned* bar = b.bar;
        __builtin_amdgcn_s_waitcnt(0);
        unsigned nloc = b.st[0], nx = b.st[1];
        if (nloc == 0u) { xcd_barrier_complete(bar, b.x, nloc, nx); b.st[0] = nloc; b.st[1] = nx; }
        const unsigned old = xb_add(&bar[XB_XSUB(b.x)], 1u);
        const unsigned gen = old / nloc;
        if (old + 1u == (gen + 1u) * nloc) {
            __builtin_amdgcn_fence(__ATOMIC_RELEASE, "agent");
            asm volatile("s_waitcnt vmcnt(0)" ::: "memory");
            const unsigned og = xb_add(&bar[XB_TOP], 1u);
            const unsigned tg = og / nx;
            if (og + 1u == (tg + 1u) * nx) xb_add(&bar[XB_TOPGEN], 1u);
            else XB_SPIN(xb_ld(&bar[XB_TOPGEN]) == tg, bar);
            __builtin_amdgcn_fence(__ATOMIC_ACQUIRE, "agent");
            xb_add(&bar[XB_XGEN(b.x)], 1u);
            asm volatile("s_waitcnt vmcnt(0)" ::: "memory");
        } else {
            XB_SPIN(xb_ld(&bar[XB_XGEN(b.x)]) == gen, bar);
            __builtin_amdgcn_fence(__ATOMIC_ACQUIRE, "agent");
            asm volatile("s_waitcnt vmcnt(0)" ::: "memory");
        }
    }
    __syncthreads();
}


__global__ void __launch_bounds__(NTHREADS, 2) fwd_megakernel(Args a) {
    extern __shared__ __attribute__((aligned(16))) unsigned char lds_raw[];
    LAS unsigned char* lds = (LAS unsigned char*)lds_raw;
    cg::grid_group grid = cg::this_grid();
    const int tid = threadIdx.x, lane = tid & 63, wave = __builtin_amdgcn_readfirstlane(tid >> 6);
    volatile LAS unsigned* bar_st = (volatile LAS unsigned*)(lds + LDS_MAIN);
    if (tid == 0) { bar_st[0] = 0u; bar_st[1] = 0u; }
    __syncthreads();
    const XcdBarrier xbar = xcd_barrier_post((unsigned*)(a.ws + WS_BAR), bar_st);
#define GRID_BAR() xcd_barrier(xbar)
    unsigned char* ws = a.ws;
    bf16_t* xb = (bf16_t*)(ws + WS_XB);
    bf16_t* act = (bf16_t*)(ws + WS_R1); bf16_t* qkvb = (bf16_t*)(ws + WS_R1); float* ubuf = (float*)(ws + WS_R1);
    bf16_t* og = (bf16_t*)(ws + WS_R2 + R2_OG); bf16_t* om = (bf16_t*)(ws + WS_R2 + R2_OM); float* lse = (float*)(ws + WS_R2 + R2_LSE);
    bf16_t* gbuf = (bf16_t*)(ws + WS_R2 + R2_GB); bf16_t* zb = (bf16_t*)(ws + WS_R2 + R2_ZB);
    float* chs = (float*)(ws + WS_CHS); const float* lamb = (const float*)(ws + WS_LAM); const float* bbb = (const float*)(ws + WS_BB);
    const int kvg_first = (65 * 22) % (int)gridDim.x, kvg_n = (int)gridDim.x - kvg_first, kvq_first = (65 * 9) % (int)gridDim.x;
#define KVSLICE_AT(part) do { int tk_ = threadIdx.x; asm volatile("" : "+v"(tk_)); kv_slice(a, (unsigned)(part), (unsigned)tk_); } while (0)
#define KVSLICE(ph) do { if ((int)blockIdx.x >= kvg_first) KVSLICE_AT((ph) * kvg_n + ((int)blockIdx.x - kvg_first)); } while (0)
#define KVSLICE_Q() do { if ((int)blockIdx.x >= kvq_first) KVSLICE_AT(4 * kvg_n + ((int)blockIdx.x - kvq_first)); } while (0)
#define SSQ(i) ((float*)(ws + WS_SSQ + (size_t)(i) * SZ_SSQ))
#define WGU(i) ((const bf16_t*)(ws + WS_WGU + (size_t)(i) * SZ_WGU))
#define WDN(i) ((const bf16_t*)(ws + WS_WD + (size_t)(i) * SZ_WD))

    _Pragma("unroll") for (int rep = 0; rep < REP_P0; ++rep) { p0_prologue(a, lds, wave, lane); GRID_BAR(); }
    if (a.ws == nullptr) grid.sync();
    _Pragma("unroll") for (int rep = 0; rep < REP_GU; ++rep) { rs_prepass(lds, SSQ(0), MT, 2 * FF, tid); EpiGU E; E.rs = (const LAS float*)(lds + RS_OFF); E.ui = 0; E.act = act; run_gemm(lds, xb, WGU(0), 2 * FF, D, E); KVSLICE(0); GRID_BAR(); }
    { EpiRes E; E.xb = xb; E.ssq_out = SSQ(1); E.scale = 0.5f; run_gemm(lds, act, WDN(0), D, FF, E, MP);
      SEpiRes S; S.xb = xb; S.ssq_out = SSQ(1); S.scale = 0.5f; sample_gemm(lds, act, WDN(0), FF, S, wave, lane); }
    GRID_BAR();
    { rs_prepass(lds, SSQ(1), MT, NQKV, tid); EpiQKV E; E.rs = (const LAS float*)(lds + RS_OFF); E.ui = 0; E.qkvb = qkvb; E.out = a.out; run_gemm(lds, xb, (const bf16_t*)(ws + WS_WQKV), NQKV, D, E); KVSLICE_Q(); }
    GRID_BAR();
    _Pragma("unroll") for (int rep = 0; rep < REP_ATT; ++rep) {
#pragma unroll 1
        for (int it = blockIdx.x; it < 1536 * REP_ATTP; it += gridDim.x) attn_prompt_item(lds, qkvb, og, lse, it % 1536, tid, wave, lane);
#pragma unroll 1
        for (int it = blockIdx.x * NWAVES + wave; it < 32 * 3 * 4 * 8 * REP_ATTS; it += gridDim.x * NWAVES) attn_sample_item(a, qkvb, og, lse, it % 3072, lane);
        GRID_BAR();
    }
    _Pragma("unroll") for (int rep = 0; rep < REP_MERGE; ++rep) { merge_phase(og, lse, om); GRID_BAR(); }
    { EpiRes E; E.xb = xb; E.ssq_out = SSQ(2); E.scale = 1.0f; run_gemm(lds, om, (const bf16_t*)(ws + WS_WO), D, AW, E, MP);
      SEpiRes S; S.xb = xb; S.ssq_out = SSQ(2); S.scale = 1.0f; sample_gemm(lds, om, (const bf16_t*)(ws + WS_WO), AW, S, wave, lane); }
    GRID_BAR();
    { rs_prepass(lds, SSQ(2), MT, 2 * FF, tid); EpiGU E; E.rs = (const LAS float*)(lds + RS_OFF); E.ui = 0; E.act = act; run_gemm(lds, xb, WGU(1), 2 * FF, D, E); KVSLICE(1); }
    GRID_BAR();
    { EpiRes E; E.xb = xb; E.ssq_out = SSQ(3); E.scale = 0.5f; run_gemm(lds, act, WDN(1), D, FF, E, MP);
      SEpiRes S; S.xb = xb; S.ssq_out = SSQ(3); S.scale = 0.5f; sample_gemm(lds, act, WDN(1), FF, S, wave, lane); }
    GRID_BAR();
    { rs_prepass(lds, SSQ(3), MT, 2 * FF, tid); EpiGU E; E.rs = (const LAS float*)(lds + RS_OFF); E.ui = 0; E.act = act; run_gemm(lds, xb, WGU(2), 2 * FF, D, E); KVSLICE(2); }
    GRID_BAR();
    { EpiRes E; E.xb = xb; E.ssq_out = SSQ(4); E.scale = 0.5f; run_gemm(lds, act, WDN(2), D, FF, E, MP);
      SEpiRes S; S.xb = xb; S.ssq_out = SSQ(4); S.scale = 0.5f; sample_gemm(lds, act, WDN(2), FF, S, wave, lane); }
    GRID_BAR();
    { rs_prepass(lds, SSQ(4), MP, D, tid); EpiU E; E.rs = (const LAS float*)(lds + RS_OFF); E.ui = 0; E.ubuf = ubuf; run_gemm(lds, xb, (const bf16_t*)(ws + WS_WIN), D, D, E, MP);
      SEpiU S; S.ssq = SSQ(4); S.ubuf = ubuf; S.ssq_out = nullptr; sample_gemm(lds, xb, (const bf16_t*)(ws + WS_WIN), D, S, wave, lane); }
    GRID_BAR();
    _Pragma("unroll") for (int rep = 0; rep < REP_SCANA; ++rep) {
        bf16x8 bop[2][4], cop[4]; float lre = 0.f, lim = 0.f, dv = 0.f; int gcur = -1;
#pragma unroll 1
        for (int it = blockIdx.x; it < 1024; it += gridDim.x) {
            const int g = it & 63, cc = it >> 6, ccp = ((cc & 3) << 2) | (cc >> 2), b = ccp >> 3, co = ccp & 7, k = co * 8 + wave;
            float hre = 0.f, him = 0.f;
            scan_run<false>(lds, wave, lane, ubuf, b * SEQ + k * 128, 128, g, lamb + (g * 64 + lane) * 4, bbb + (g * 64 + lane) * 32, nullptr, nullptr, nullptr, nullptr, hre, him, g != gcur, bop, cop, lre, lim, dv);
            gcur = g;
            float* d = chs + ((((size_t)b * 64 + k) * 64 + g) * 64 + lane) * 2; d[0] = hre; d[1] = him;
        }
#pragma unroll 1
        for (int it = blockIdx.x; it < 256; it += gridDim.x) {
            const int bo = it & 3, g = it >> 2, b = bo * 8 + wave;
            const float* st = a.in[5] + (((size_t)b * 64 + g) * 64 + lane) * 2;
            float hre = st[0], him = st[1];
            scan_run<true>(lds, wave, lane, ubuf, MP + b * 8, 8, g, lamb + (g * 64 + lane) * 4, bbb + (g * 64 + lane) * 32, a.in[21], a.in[19], a.in[20], gbuf, hre, him, true, bop, cop, lre, lim, dv);
            float* d = a.out + O_SSMS + (((size_t)b * 64 + g) * 64 + lane) * 2; d[0] = hre; d[1] = him;
        }
        GRID_BAR();
    }
    _Pragma("unroll") for (int rep = 0; rep < REP_SCANC; ++rep) {
        bf16x8 bop[2][4], cop[4]; float lre = 0.f, lim = 0.f, dv = 0.f; int gcur = -1, bprev = -1, kprev = -100;
        float hre = 0.f, him = 0.f, pre = 0.f, pim = 0.f;
#pragma unroll 1
        for (int it = blockIdx.x; it < 1024; it += gridDim.x) {
            const int g = it & 63, cc = it >> 6, ccp = ((cc & 3) << 2) | (cc >> 2), b = ccp >> 3, co = ccp & 7, k = co * 8 + wave;
            const bool reload = g != gcur;
            if (reload) { const float* lp = lamb + (g * 64 + lane) * 4; pre = lp[2]; pim = lp[3]; }
            int jstart = 0;
            if (!reload && b == bprev && k == kprev + 8) jstart = kprev + 1;
            else { hre = 0.f; him = 0.f; }
#pragma unroll 1
            for (int j0 = jstart; j0 < k; j0 += 8) {
                float sr[8], si[8];
#pragma unroll
                for (int u = 0; u < 8; ++u) { const int j = (j0 + u < k) ? j0 + u : j0; const float* sp = chs + ((((size_t)b * 64 + j) * 64 + g) * 64 + lane) * 2; sr[u] = sp[0]; si[u] = sp[1]; }
#pragma unroll
                for (int u = 0; u < 8; ++u) if (j0 + u < k) { const float nre = pre * hre - pim * him + sr[u], nim = pre * him + pim * hre + si[u]; hre = nre; him = nim; }
            }
            scan_run<true>(lds, wave, lane, ubuf, b * SEQ + k * 128, 128, g, lamb + (g * 64 + lane) * 4, bbb + (g * 64 + lane) * 32, a.in[21], a.in[19], a.in[20], gbuf, hre, him, reload, bop, cop, lre, lim, dv);
            gcur = g; bprev = b; kprev = k;
            if (k == 63) { float* d = a.out + O_SSMP + (((size_t)b * 64 + g) * 64 + lane) * 2; d[0] = hre; d[1] = him; }
        }
        GRID_BAR();
    }
    { EpiGLU E; E.gbuf = gbuf; E.bglu = a.in[23]; E.zb = zb; run_gemm(lds, gbuf, (const bf16_t*)(ws + WS_WGLU), D, D, E, MP);
      SEpiGLU S; S.gbuf = gbuf; S.bglu = a.in[23]; S.zb = zb; S.ssq_out = nullptr; sample_gemm(lds, gbuf, (const bf16_t*)(ws + WS_WGLU), D, S, wave, lane); }
    GRID_BAR();
    { EpiRes E; E.xb = xb; E.ssq_out = SSQ(5); E.scale = 1.0f; run_gemm(lds, zb, (const bf16_t*)(ws + WS_WOUT), D, D, E, MP);
      SEpiRes S; S.xb = xb; S.ssq_out = SSQ(5); S.scale = 1.0f; sample_gemm(lds, zb, (const bf16_t*)(ws + WS_WOUT), D, S, wave, lane); }
    GRID_BAR();
    { rs_prepass(lds, SSQ(5), MT, 2 * FF, tid); EpiGU E; E.rs = (const LAS float*)(lds + RS_OFF); E.ui = 0; E.act = act; run_gemm(lds, xb, WGU(3), 2 * FF, D, E); KVSLICE(3); }
    GRID_BAR();
    { EpiRes E; E.xb = xb; E.ssq_out = SSQ(6); E.scale = 0.5f; run_gemm(lds, act, WDN(3), D, FF, E, MP);
      SEpiRes S; S.xb = xb; S.ssq_out = SSQ(6); S.scale = 0.5f; sample_gemm(lds, act, WDN(3), FF, S, wave, lane); }
    GRID_BAR();
    _Pragma("unroll") for (int rep = 0; rep < REP_FINAL; ++rep) {
        const float* gf = a.in[7]; const float* ssq6 = SSQ(6);
        for (int row = blockIdx.x * NWAVES + wave; row < MT; row += gridDim.x * NWAVES) {
            const float s = row_scale(ssq6, row);
#pragma unroll
            for (int j = 0; j < 2; ++j) { const int col = 512 * j + 8 * lane; const u32x4 r = *(const u32x4*)(xb + (size_t)row * D + col);
                const f32x4 g0 = *(const f32x4*)(gf + col), g1 = *(const f32x4*)(gf + col + 4); f32x4 v0, v1;
                v0[0] = __uint_as_float(r.x << 16); v0[1] = __uint_as_float(r.x & 0xffff0000u); v0[2] = __uint_as_float(r.y << 16); v0[3] = __uint_as_float(r.y & 0xffff0000u);
                v1[0] = __uint_as_float(r.z << 16); v1[1] = __uint_as_float(r.z & 0xffff0000u); v1[2] = __uint_as_float(r.w << 16); v1[3] = __uint_as_float(r.w & 0xffff0000u);
                *(f32x4*)(a.out + O_Y + (size_t)row * D + col) = v0 * s * g0; *(f32x4*)(a.out + O_Y + (size_t)row * D + col + 4) = v1 * s * g1; }
        }
    }
}

extern "C" void kernel_launch(void* const* d_in, const int* in_sizes, int n_in, void* d_out, int out_size, void* d_ws, size_t ws_size, hipStream_t stream) {
    static int grid_blocks = 0;
    if (grid_blocks == 0) {
        if (n_in != 25 || (size_t)out_size != O_END || ws_size < WS_END) { fprintf(stderr, "kernel_launch: unexpected shapes: n_in %d out %d (want %zu) ws %zu (want >= %zu)\n", n_in, out_size, (size_t)O_END, ws_size, (size_t)WS_END); grid_blocks = -1; return; }
        int dev = 0, cus = 0, per_cu = 0;
        hipGetDevice(&dev); hipDeviceGetAttribute(&cus, hipDeviceAttributeMultiprocessorCount, dev);
        if (hipFuncSetAttribute((const void*)fwd_megakernel, hipFuncAttributeMaxDynamicSharedMemorySize, LDS_BYTES) != hipSuccess) { fprintf(stderr, "kernel_launch: hipFuncSetAttribute failed\n"); grid_blocks = -1; return; }
        if (hipOccupancyMaxActiveBlocksPerMultiprocessor(&per_cu, (const void*)fwd_megakernel, NTHREADS, LDS_BYTES) != hipSuccess || per_cu < 1) { fprintf(stderr, "kernel_launch: occupancy query failed (%d)\n", per_cu); grid_blocks = -1; return; }
        grid_blocks = cus * per_cu;
    }
    if (grid_blocks < 0) return;
    Args a{};
    for (int i = 0; i < 25; ++i) a.in[i] = (const float*)d_in[i];
    a.out = (float*)d_out; a.ws = (unsigned char*)d_ws;
    if (hipMemsetAsync((char*)d_ws + WS_BAR, 0, 16384, stream) != hipSuccess) { fprintf(stderr, "kernel_launch: hipMemsetAsync of the barrier words failed\n"); return; }
    void* args[] = {&a};
    hipError_t e = hipLaunchCooperativeKernel((const void*)fwd_megakernel, dim3(grid_blocks), dim3(NTHREADS), args, LDS_BYTES, stream);
    if (e != hipSuccess) fprintf(stderr, "cooperative launch failed: %s (grid %d)\n", hipGetErrorString(e), grid_blocks);
}
```
